# Optimizing an MI355X kernel written in HIP

```python
import math
import jax, jax.numpy as jnp
from jax import lax
import numpy as np

D_MODEL = 2048
BATCH = 16
SEQ = 2048
DEPTH = 1
DEC_BATCH = 8
DEC_SEQ = 16
PAST_LEN = 1024

CHUNK = 64
Q_BLOCK = 128
H_A = 8
DH_A = 64
DK_A = 2 * DH_A
DV_A = 128
H_B = 8
DH_B = 128
N_PREV_CHUNKS = 8
BAND_PAST = N_PREV_CHUNKS * CHUNK
BAND_LEN = BAND_PAST + CHUNK
MAX_REL = 128
H_C = 4
DH_C = 256
N_MEM = 256
N_BRANCH = 3
W_A = H_A * DV_A
W_B = H_B * DH_B
W_C = H_C * DH_C
D_FF = ((8 * D_MODEL + 3 * 256 - 1) // (3 * 256)) * 256
IN_SIZES = [H_A * DK_A, H_A * DK_A, W_A, W_B, W_B, W_B, W_C, N_BRANCH * D_MODEL]
N_IN = sum(IN_SIZES)
SPLIT_IDX = [int(i) for i in np.cumsum(IN_SIZES)[:-1]]
EPS = 1e-6
NEG_INF = -1e30

kernel_name = "gated_hybrid_streaming_encoder_step"


def rms_norm(x, g):
    xf = x.astype(jnp.float32)
    y = xf * lax.rsqrt(jnp.mean(xf * xf, axis=-1, keepdims=True) + EPS) * g.astype(jnp.float32)
    return y.astype(x.dtype)


def head_norm(o, g, lam_init):
    of = o.astype(jnp.float32)
    y = of * lax.rsqrt(jnp.mean(of * of, axis=-1, keepdims=True) + EPS) * g.astype(jnp.float32) * (1.0 - lam_init)
    return y.astype(o.dtype)


def alibi_slopes():
    return jnp.asarray([2.0 ** (-8.0 * (h + 1) / H_A) for h in range(H_A)], dtype=jnp.float32)


def diff_lambda(lq1, lk1, lq2, lk2, lam_init):
    f = lambda a: a.astype(jnp.float32)
    return jnp.exp(jnp.sum(f(lq1) * f(lk1))) - jnp.exp(jnp.sum(f(lq2) * f(lk2))) + lam_init


def diff_attend(q, k, v, qpos, kpos, lam):
    q1, q2 = jnp.split(q, 2, axis=-1)
    k1, k2 = jnp.split(k, 2, axis=-1)
    dist = jnp.abs(qpos[:, None] - kpos[None, :]).astype(jnp.float32)
    bias = -alibi_slopes()[:, None, None] * dist[None]
    visible = (kpos[None, :] // CHUNK) <= (qpos[:, None] // CHUNK)
    scale = DH_A ** -0.5

    def probs(qa, ka):
        s = jnp.einsum("bqhd,bkhd->bhqk", qa, ka).astype(jnp.float32) * scale + bias[None]
        return jax.nn.softmax(jnp.where(visible[None, None], s, NEG_INF), axis=-1)

    a = probs(q1, k1) - lam * probs(q2, k2)
    return jnp.einsum("bhqk,bkhd->bqhd", a.astype(v.dtype), v)


def diff_attention_prompt(q, k, v, lam):
    B, S = q.shape[0], q.shape[1]
    nb = S // Q_BLOCK
    kpos = jnp.arange(S)
    qb = q.reshape(B, nb, Q_BLOCK, H_A, DK_A).transpose(1, 0, 2, 3, 4)

    def step(args):
        qblk, i = args
        qpos = i * Q_BLOCK + jnp.arange(Q_BLOCK)
        return diff_attend(qblk, k, v, qpos, kpos, lam)

    o = lax.map(step, (qb, jnp.arange(nb)))
    return o.transpose(1, 0, 2, 3, 4).reshape(B, S, H_A, DV_A)


def band_attend(q, k, v, qpos, kpos, rel_bias):
    s = jnp.einsum("bqhd,bkhd->bhqk", q, k).astype(jnp.float32) * (DH_B ** -0.5)
    rel = jnp.clip(kpos[None, :] - qpos[:, None], -MAX_REL, MAX_REL) + MAX_REL
    s = s + jnp.take(rel_bias, rel, axis=1).astype(jnp.float32)[None]
    qch = qpos[:, None] // CHUNK
    kch = kpos[None, :] // CHUNK
    valid = (kpos[None, :] >= 0) & (kch <= qch) & (kch >= qch - N_PREV_CHUNKS)
    p = jax.nn.softmax(jnp.where(valid[None, None], s, NEG_INF), axis=-1)
    return jnp.einsum("bhqk,bkhd->bqhd", p.astype(v.dtype), v)


def band_attention_prompt(q, k, v, rel_bias):
    B, S = q.shape[0], q.shape[1]
    nc = S // CHUNK
    pad = ((0, 0), (BAND_PAST, 0), (0, 0), (0, 0))
    kpad = jnp.pad(k, pad)
    vpad = jnp.pad(v, pad)
    qc = q.reshape(B, nc, CHUNK, H_B, DH_B).transpose(1, 0, 2, 3, 4)

    def step(args):
        qchunk, c = args
        start = c * CHUNK
        kb = lax.dynamic_slice_in_dim(kpad, start, BAND_LEN, axis=1)
        vb = lax.dynamic_slice_in_dim(vpad, start, BAND_LEN, axis=1)
        qpos = start + jnp.arange(CHUNK)
        kpos = start - BAND_PAST + jnp.arange(BAND_LEN)
        return band_attend(qchunk, kb, vb, qpos, kpos, rel_bias)

    o = lax.map(step, (qc, jnp.arange(nc)))
    return o.transpose(1, 0, 2, 3, 4).reshape(B, S, H_B, DH_B)


def memory_kv(mem, g, w_mem_kv):
    B = mem.shape[0]
    m = rms_norm(mem, g) @ w_mem_kv
    mk, mv = jnp.split(m, 2, axis=-1)
    return mk.reshape(B, N_MEM, H_C, DH_C), mv.reshape(B, N_MEM, H_C, DH_C)


def cross_attend(q, mk, mv):
    s = jnp.einsum("bqhd,bkhd->bhqk", q, mk).astype(jnp.float32) * (DH_C ** -0.5)
    p = jax.nn.softmax(s, axis=-1)
    return jnp.einsum("bhqk,bkhd->bqhd", p.astype(mv.dtype), mv)


def swiglu(h, w_ffn_in, w_ffn_out):
    a, b = jnp.split(h @ w_ffn_in, 2, axis=-1)
    return (jax.nn.silu(a) * b) @ w_ffn_out


def layer_forward(x, mk, mv, attend_a, attend_b, lam_init, norm_mix_pre, norm_mix_post, w_in, b_gate,
                  subln_a, w_br_a, w_br_b, w_br_c, w_out, norm_ffn_pre, norm_ffn_post, w_ffn_in, w_ffn_out):
    B, T, _ = x.shape
    h = rms_norm(x, norm_mix_pre)
    q_a, k_a, v_a, q_b, k_b, v_b, q_c, g = jnp.split(h @ w_in, SPLIT_IDX, axis=-1)
    q_a = q_a.reshape(B, T, H_A, DK_A)
    k_a = k_a.reshape(B, T, H_A, DK_A)
    v_a = v_a.reshape(B, T, H_A, DV_A)
    q_b = q_b.reshape(B, T, H_B, DH_B)
    k_b = k_b.reshape(B, T, H_B, DH_B)
    v_b = v_b.reshape(B, T, H_B, DH_B)
    q_c = q_c.reshape(B, T, H_C, DH_C)
    o_a = head_norm(attend_a(q_a, k_a, v_a), subln_a, lam_init).reshape(B, T, W_A)
    o_b = attend_b(q_b, k_b, v_b).reshape(B, T, W_B)
    o_c = cross_attend(q_c, mk, mv).reshape(B, T, W_C)
    gates = jax.nn.sigmoid(g + b_gate).reshape(B, T, N_BRANCH, D_MODEL)
    merged = (gates[..., 0, :] * (o_a @ w_br_a) + gates[..., 1, :] * (o_b @ w_br_b)
              + gates[..., 2, :] * (o_c @ w_br_c))
    x = x + rms_norm(merged @ w_out, norm_mix_post)
    x = x + rms_norm(swiglu(rms_norm(x, norm_ffn_pre), w_ffn_in, w_ffn_out), norm_ffn_post)
    return x, k_a, v_a, k_b, v_b


def setup_inputs(seed: int = 0) -> dict:
    key = jax.random.key(seed)
    ks = iter(jax.random.split(key, 48))
    nrm = lambda shape, scale: scale * jax.random.normal(next(ks), shape, jnp.float32)
    gain = lambda n: 1.0 + nrm((DEPTH, n), 0.05)
    lb = min(BAND_PAST, PAST_LEN)
    return {
        "x_prompt": nrm((BATCH, SEQ, D_MODEL), 1.0),
        "x_sample": nrm((DEC_BATCH, DEC_SEQ, D_MODEL), 1.0),
        "cache_a_k": nrm((DEPTH, DEC_BATCH, PAST_LEN, H_A, DK_A), 1.0),
        "cache_a_v": nrm((DEPTH, DEC_BATCH, PAST_LEN, H_A, DV_A), 1.0),
        "cache_b_k": nrm((DEPTH, DEC_BATCH, lb, H_B, DH_B), 1.0),
        "cache_b_v": nrm((DEPTH, DEC_BATCH, lb, H_B, DH_B), 1.0),
        "cache_mem_k": nrm((DEPTH, DEC_BATCH, N_MEM, H_C, DH_C), 1.0),
        "cache_mem_v": nrm((DEPTH, DEC_BATCH, N_MEM, H_C, DH_C), 1.0),
        "mem_prompt": nrm((BATCH, N_MEM, D_MODEL), 1.0),
        "norm_mix_pre": gain(D_MODEL),
        "norm_mix_post": gain(D_MODEL),
        "norm_mem": gain(D_MODEL),
        "w_in": nrm((DEPTH, D_MODEL, N_IN), D_MODEL ** -0.5),
        "b_gate": nrm((DEPTH, N_BRANCH * D_MODEL), 0.1),
        "lambda_q1": nrm((DEPTH, DH_A), 0.1),
        "lambda_k1": nrm((DEPTH, DH_A), 0.1),
        "lambda_q2": nrm((DEPTH, DH_A), 0.1),
        "lambda_k2": nrm((DEPTH, DH_A), 0.1),
        "subln_a": gain(DV_A),
        "rel_bias_b": nrm((DEPTH, H_B, 2 * MAX_REL + 1), 0.1),
        "w_mem_kv": nrm((DEPTH, D_MODEL, 2 * W_C), D_MODEL ** -0.5),
        "w_br_a": nrm((DEPTH, W_A, D_MODEL), W_A ** -0.5),
        "w_br_b": nrm((DEPTH, W_B, D_MODEL), W_B ** -0.5),
        "w_br_c": nrm((DEPTH, W_C, D_MODEL), W_C ** -0.5),
        "w_out": nrm((DEPTH, D_MODEL, D_MODEL), D_MODEL ** -0.5),
        "norm_ffn_pre": gain(D_MODEL),
        "norm_ffn_post": gain(D_MODEL),
        "w_ffn_in": nrm((DEPTH, D_MODEL, 2 * D_FF), D_MODEL ** -0.5),
        "w_ffn_out": nrm((DEPTH, D_FF, D_MODEL), D_FF ** -0.5),
    }


def reference(x_prompt, x_sample, cache_a_k, cache_a_v, cache_b_k, cache_b_v, cache_mem_k, cache_mem_v,
              mem_prompt, norm_mix_pre, norm_mix_post, norm_mem, w_in, b_gate, lambda_q1, lambda_k1,
              lambda_q2, lambda_k2, subln_a, rel_bias_b, w_mem_kv, w_br_a, w_br_b, w_br_c, w_out,
              norm_ffn_pre, norm_ffn_post, w_ffn_in, w_ffn_out):
    S = x_prompt.shape[1]
    T = x_sample.shape[1]
    P = cache_a_k.shape[2]
    Lb = cache_b_k.shape[2]
    Lb_prompt = min(BAND_PAST, S)
    yp, ys = x_prompt, x_sample
    akp, avp, bkp, bvp, mkp, mvp, aks, avs, bks, bvs = ([] for _ in range(10))
    for l in range(DEPTH):
        lam_init = 0.8 - 0.6 * math.exp(-0.3 * l)
        lam = diff_lambda(lambda_q1[l], lambda_k1[l], lambda_q2[l], lambda_k2[l], lam_init)
        shared = (lam_init, norm_mix_pre[l], norm_mix_post[l], w_in[l], b_gate[l], subln_a[l], w_br_a[l],
                  w_br_b[l], w_br_c[l], w_out[l], norm_ffn_pre[l], norm_ffn_post[l], w_ffn_in[l], w_ffn_out[l])
        rb = rel_bias_b[l]

        mk_p, mv_p = memory_kv(mem_prompt, norm_mem[l], w_mem_kv[l])
        attend_a_p = lambda q, k, v, lam=lam: diff_attention_prompt(q, k, v, lam)
        attend_b_p = lambda q, k, v, rb=rb: band_attention_prompt(q, k, v, rb)
        yp, ka, va, kb, vb = layer_forward(yp, mk_p, mv_p, attend_a_p, attend_b_p, *shared)
        akp.append(ka)
        avp.append(va)
        bkp.append(kb[:, S - Lb_prompt:])
        bvp.append(vb[:, S - Lb_prompt:])
        mkp.append(mk_p)
        mvp.append(mv_p)

        ca_k, ca_v, cb_k, cb_v = cache_a_k[l], cache_a_v[l], cache_b_k[l], cache_b_v[l]
        qpos = P + jnp.arange(T)

        def attend_a_s(q, k, v, lam=lam, ca_k=ca_k, ca_v=ca_v, qpos=qpos):
            k_all = jnp.concatenate([ca_k, k], axis=1)
            v_all = jnp.concatenate([ca_v, v], axis=1)
            return diff_attend(q, k_all, v_all, qpos, jnp.arange(P + T), lam)

        def attend_b_s(q, k, v, rb=rb, cb_k=cb_k, cb_v=cb_v, qpos=qpos):
            k_all = jnp.concatenate([cb_k, k], axis=1)
            v_all = jnp.concatenate([cb_v, v], axis=1)
            return band_attend(q, k_all, v_all, qpos, P - Lb + jnp.arange(Lb + T), rb)

        ys, ka, va, kb, vb = layer_forward(ys, cache_mem_k[l], cache_mem_v[l], attend_a_s, attend_b_s, *shared)
        aks.append(ka)
        avs.append(va)
        bks.append(kb)
        bvs.append(vb)

    return (yp, ys, jnp.stack(akp), jnp.stack(avp), jnp.stack(bkp), jnp.stack(bvp), jnp.stack(mkp),
            jnp.stack(mvp), jnp.stack(aks), jnp.stack(avs), jnp.stack(bks), jnp.stack(bvs))
```

```cpp
#include <hip/hip_runtime.h>
#include <hip/hip_cooperative_groups.h>
#include <cstdio>
#include <cstdint>
namespace cg = cooperative_groups;

constexpr int DM = 2048, MP = 32768, MS = 128, MT = 33024;
constexpr int NIN = 13312, NQKV = 7168, NG = 6144, DFF = 5632, NMEMROWS = 4096;
constexpr float EPS = 1e-6f, LOG2E = 1.4426950408889634f;
constexpr float SC_A = 0.125f * LOG2E, SC_B = 0.08838834764831845f * LOG2E, SC_C = 0.0625f * LOG2E;
constexpr long OFF_Y = 0, OFF_YS = 67108864L, OFF_AKP = OFF_YS + 262144L, OFF_AVP = OFF_AKP + 33554432L, OFF_BKP = OFF_AVP + 33554432L,
               OFF_BVP = OFF_BKP + 8388608L, OFF_MKP = OFF_BVP + 8388608L, OFF_MVP = OFF_MKP + 4194304L, OFF_AKS = OFF_MVP + 4194304L,
               OFF_AVS = OFF_AKS + 131072L, OFF_BKS = OFF_AVS + 131072L, OFF_BVS = OFF_BKS + 131072L, OUT_TOTAL = OFF_BVS + 131072L;
constexpr size_t WS_WIN = 0, WS_WMEM = WS_WIN + (size_t)NIN * DM * 2, WS_WBR = WS_WMEM + (size_t)DM * DM * 2, WS_WOUT = WS_WBR + (size_t)DM * 3072 * 2,
                 WS_WFFI = WS_WOUT + (size_t)DM * DM * 2, WS_WFFO = WS_WFFI + (size_t)2 * DFF * DM * 2, WS_QKV = WS_WFFO + (size_t)DM * DFF * 2,
                 WS_G = WS_QKV + (size_t)MT * NQKV * 2, WS_MEMN = WS_G + (size_t)MT * NG * 2, WS_MKP = WS_MEMN + (size_t)NMEMROWS * DM * 2,
                 WS_MVP = WS_MKP + (size_t)NMEMROWS * 1024 * 2, WS_END = WS_MVP + (size_t)NMEMROWS * 1024 * 2;
constexpr size_t WS_CTL = WS_END;
static_assert(WS_CTL % 256 == 0 && WS_CTL + 16384 <= 1073741824ull, "d_ws map");
constexpr size_t WS_MERGED = WS_QKV, WS_T = WS_QKV + (size_t)MT * DM * 2, WS_ACT = WS_QKV;
constexpr size_t WS_TS = WS_QKV + (size_t)MT * DM * 4, WS_US = WS_QKV + (size_t)MT * DFF * 2;
constexpr size_t WS_PS = WS_TS + (size_t)12 * 256 * DM * 4;
static_assert(WS_PS + (size_t)3 * 256 * DM * 2 <= WS_G && WS_US + (size_t)11 * 256 * DM * 4 <= WS_G, "partials");
constexpr size_t WS_X1 = WS_G, WS_H2 = WS_G + (size_t)MT * DM * 2;
static_assert(WS_T + (size_t)MT * DM * 4 <= WS_G && WS_H2 + (size_t)MT * DM * 2 <= WS_MEMN && WS_ACT + (size_t)MT * DFF * 2 <= WS_G, "overlays");
constexpr size_t YS_XN = 0, YS_OB = 0, YS_KAC = 203423744ull, YS_VAC = YS_KAC + 16777216ull, YS_KBC = YS_VAC + 16777216ull, YS_VBC = YS_KBC + 8388608ull,
                 YS_MKC = YS_VBC + 8388608ull, YS_MVC = YS_MKC + 4194304ull, YS_END = YS_MVC + 4194304ull;
static_assert((size_t)MT * 3072 * 2 <= YS_KAC && YS_END <= 268435456ull, "y scratch map");

#define LAS __attribute__((address_space(3)))
namespace pg8 {
#define PG8_LAS __attribute__((address_space(3)))
typedef unsigned short bf16_t;
typedef short bf16x8 __attribute__((ext_vector_type(8)));
typedef float f32x4 __attribute__((ext_vector_type(4)));
typedef unsigned u32x4 __attribute__((ext_vector_type(4)));
constexpr int BM = 256, BK = 64, HALF = 128, HTB = HALF * BK * 2  , STAGE_BYTES = 8 * HTB, NXCD = 8, WGM = 4;

__host__ __device__ __forceinline__ int lds_byte(int r, int c) { const int st = (r >> 4) * 2 + (c >> 5), rr = r & 15, cc = c & 31, ob = rr * 64 + cc * 2; return st * 1024 + (ob ^ (((ob >> 9) & 1) << 5)); }
__host__ __device__ __forceinline__ void stage_rc(int b, int& R, int& C) { const int st = b / 1024, sb = b % 1024, swz = sb ^ (((sb >> 9) & 1) << 5); R = (st >> 1) * 16 + swz / 64; C = (st & 1) * 32 + (swz % 64) / 2; }
__host__ __device__ __forceinline__ int perm32(int rho) { const int n = rho >> 4, i = rho & 15; return 8 * (i >> 2) + 4 * n + (i & 3); }

struct Unit { int pm, pn, kind, aux; };
struct Gemm { const bf16_t* A; const bf16_t* Bt; int M, N, K; };

struct StaticOrder {
    int nM, nN, nwg, G, c;
    __host__ __device__ void init(int M, int N, int G_, int c_) { nM = M / BM; nN = N / BM; nwg = nM * nN; G = G_; c = c_; }
    __host__ __device__ bool next(int i, Unit& u) const {
        const long L = (long)i * G + c; if (L >= nwg) return false;
        int wgid = (int)L; { const int q = nwg / NXCD, r = nwg % NXCD, xcd = wgid % NXCD, off = wgid / NXCD; wgid = (xcd < r ? xcd * (q + 1) : r * (q + 1) + (xcd - r) * q) + off; }
        const int nig = WGM * nN, gid = wgid / nig, fm = gid * WGM, gsz = (nM - fm) < WGM ? (nM - fm) : WGM;
        u.pm = fm + ((wgid % nig) % gsz); u.pn = (wgid % nig) / gsz; return true;
    }
    __device__ __forceinline__ void a_ready(const Unit&) const {}
    __device__ __forceinline__ void done(const Unit&) const {}
};


struct PhaseSched {
    StaticOrder so; int n0, n1, G, c, mode, nt0;
    const char *A0, *B0, *A1, *B1;
    __device__ __forceinline__ bool next(int i, Unit& u) const {
        const long L = (long)i * G + c;
        if (L < n0) { so.next(i, u); u.kind = 0; u.aux = 0; return true; }
        if (L >= n0 + n1) return false;
        const int j = (int)L - n0; u.aux = 0;
        if (mode == 1) { if (j < 52) { u.kind = 0; u.pm = 128; u.pn = j; } else { u.kind = 1; u.pm = (j - 52) >> 3; u.pn = (j - 52) & 7; } }
        else { u.kind = 1; u.pm = 0; u.pn = j & 7; u.aux = j >> 3; }
        return true;
    }
    __device__ __forceinline__ size_t aoff(int aux) const { return mode == 3 ? (size_t)aux * 2048 : (mode == 4 ? (size_t)(aux >> 2) * 1048576 + (size_t)(aux & 3) * 1024 : (size_t)aux * 1024); }
    __device__ __forceinline__ size_t boff(int aux) const { return mode == 3 ? (size_t)aux * 2048 : (mode == 4 ? (size_t)(aux & 3) * 1024 : (size_t)aux * 1024); }
    __device__ __forceinline__ const char* abase(const Unit& u, size_t tstep) const { return u.kind == 0 ? A0 + (size_t)u.pm * tstep : A1 + (size_t)u.pm * tstep + aoff(u.aux); }
    __device__ __forceinline__ const char* bbase(const Unit& u, size_t tstep) const { return u.kind == 0 ? B0 + (size_t)u.pn * tstep : B1 + (size_t)u.pn * tstep + boff(u.aux); }
    __device__ __forceinline__ int nt(const Unit& u) const { return (u.kind == 0 || mode == 1) ? nt0 : (mode == 3 ? 16 : 8); }
    __device__ __forceinline__ void a_ready(const Unit&) const {}
    __device__ __forceinline__ void done(const Unit&) const {}
};
typedef float f32x2 __attribute__((ext_vector_type(2)));
typedef __bf16 bf16x2v __attribute__((ext_vector_type(2)));
__device__ __forceinline__ unsigned cvt_pk_bf16(float lo, float hi) { f32x2 v = {lo, hi}; bf16x2v b = __builtin_convertvector(v, bf16x2v); return __builtin_bit_cast(unsigned, b); }
__device__ __forceinline__ u32x4 pack8(f32x4 v0, f32x4 v1) { u32x4 w; w.x = cvt_pk_bf16(v0[0], v0[1]); w.y = cvt_pk_bf16(v0[2], v0[3]); w.z = cvt_pk_bf16(v1[0], v1[1]); w.w = cvt_pk_bf16(v1[2], v1[3]); return w; }
__device__ __forceinline__ float bflo(unsigned w) { return __uint_as_float(w << 16); }
__device__ __forceinline__ float bfhi(unsigned w) { return __uint_as_float(w & 0xffff0000u); }
__device__ __forceinline__ float sigmoidf_(float x) { return __builtin_amdgcn_rcpf(1.0f + __builtin_amdgcn_exp2f(-x * LOG2E)); }

struct EpiQKV {
    static constexpr bool PERM = true, HOOK = false;
    bf16_t* QKV; bf16_t* G; const float* bgate; float* out;
    __device__ __forceinline__ void operator()(const f32x4 (&acc)[2][2][4][2], const Unit& u, int wr, int wc, int fr, int fq) const {
        const int colt = u.pn * BM, seg = colt >> 10, row0 = u.pm * BM + wr * 64 + fr, cl = wc * 32 + fq * 8;
        if (seg < 7) {
            const float sc = seg == 0 ? SC_A : (seg == 3 ? SC_B : (seg == 6 ? SC_C : 1.f));
            const bool f32o = (seg == 1 || seg == 2 || seg == 4 || seg == 5), isb = seg >= 4;
            const long ob_p = seg == 1 ? OFF_AKP : (seg == 2 ? OFF_AVP : (seg == 4 ? OFF_BKP : OFF_BVP));
            const long ob_s = seg == 1 ? OFF_AKS : (seg == 2 ? OFF_AVS : (seg == 4 ? OFF_BKS : OFF_BVS));
#pragma unroll
            for (int ai = 0; ai < 2; ++ai)
#pragma unroll
                for (int m = 0; m < 4; ++m) {
                    const int row = row0 + ai * HALF + m * 16;
                    float* fo = nullptr;
                    if (f32o) {
                        if (row < MP) { if (!isb) fo = out + ob_p + (long)row * 1024; else { const int s = row & 2047; if (s >= 1536) fo = out + ob_p + ((long)(row >> 11) * 512 + (s - 1536)) * 1024; } }
                        else if (row < MP + MS) fo = out + ob_s + (long)(row - MP) * 1024;
                    }
#pragma unroll
                    for (int bj = 0; bj < 2; ++bj) {
                        const int col = colt + bj * HALF + cl; const f32x4 v0 = acc[ai][bj][m][0], v1 = acc[ai][bj][m][1];
                        *(u32x4*)(QKV + (size_t)row * NQKV + col) = pack8(v0 * sc, v1 * sc);
                        if (fo) { const int c1 = col & 1023; *(f32x4*)(fo + c1) = v0; *(f32x4*)(fo + c1 + 4) = v1; }
                    }
                }
        } else {
#pragma unroll
            for (int bj = 0; bj < 2; ++bj) {
                const int gc = colt - NQKV + bj * HALF + cl; const f32x4 b0 = *(const f32x4*)(bgate + gc), b1 = *(const f32x4*)(bgate + gc + 4);
#pragma unroll
                for (int ai = 0; ai < 2; ++ai)
#pragma unroll
                    for (int m = 0; m < 4; ++m) {
                        const int row = row0 + ai * HALF + m * 16; f32x4 v0 = acc[ai][bj][m][0] + b0, v1 = acc[ai][bj][m][1] + b1;
#pragma unroll
                        for (int e = 0; e < 4; ++e) { v0[e] = fmaxf(sigmoidf_(v0[e]), 1e-6f); v1[e] = fmaxf(sigmoidf_(v1[e]), 1e-6f); }
                        *(u32x4*)(G + (size_t)row * NG + gc) = pack8(v0, v1);
                    }
            }
        }
    }
};
struct EpiMem {
    static constexpr bool PERM = true, HOOK = false;
    bf16_t* MK; bf16_t* MV; float* out;
    __device__ __forceinline__ void operator()(const f32x4 (&acc)[2][2][4][2], const Unit& u, int wr, int wc, int fr, int fq) const {
        const int colt = u.pn * BM, isv = colt >> 10, row0 = u.pm * BM + wr * 64 + fr, cl = (colt & 1023) + wc * 32 + fq * 8;
        bf16_t* B = isv ? MV : MK; float* F = out + (isv ? OFF_MVP : OFF_MKP);
#pragma unroll
        for (int ai = 0; ai < 2; ++ai)
#pragma unroll
            for (int m = 0; m < 4; ++m) {
                const int row = row0 + ai * HALF + m * 16;
#pragma unroll
                for (int bj = 0; bj < 2; ++bj) {
                    const int col = bj * HALF + cl; const f32x4 v0 = acc[ai][bj][m][0], v1 = acc[ai][bj][m][1];
                    *(u32x4*)(B + (size_t)row * 1024 + col) = pack8(v0, v1);
                    *(f32x4*)(F + (size_t)row * 1024 + col) = v0; *(f32x4*)(F + (size_t)row * 1024 + col + 4) = v1;
                }
            }
    }
};
struct EpiP1 {
    static constexpr bool PERM = true, HOOK = false;
    EpiQKV q; EpiMem m;
    __device__ __forceinline__ void operator()(const f32x4 (&acc)[2][2][4][2], const Unit& u, int wr, int wc, int fr, int fq) const { if (u.kind == 0) q(acc, u, wr, wc, fr, fq); else m(acc, u, wr, wc, fr, fq); }
};
struct EpiMerge {
    static constexpr bool PERM = true, HOOK = true;
    const bf16_t* G; bf16_t* O; bf16_t* PS;
    __device__ __forceinline__ void hook(f32x4 (&acc)[2][2][4][2], const Unit& u, int seg, int wr, int wc, int fr, int fq) const {
        const int row0 = u.pm * BM + wr * 64 + fr, col0 = u.pn * BM + wc * 32 + fq * 8;
        const bf16_t* gp0 = G + (size_t)row0 * NG + (size_t)(seg - 1) * DM + col0;
#pragma unroll
        for (int ai = 0; ai < 2; ++ai) {
            u32x4 ga[4][2], gb[4][2];
#pragma unroll
            for (int m = 0; m < 4; ++m)
#pragma unroll
                for (int bj = 0; bj < 2; ++bj) { const bf16_t* gp = gp0 + (size_t)(ai * HALF + m * 16) * NG + bj * HALF; ga[m][bj] = *(const u32x4*)(gp); gb[m][bj] = *(const u32x4*)(gp + DM); }
#pragma unroll
            for (int m = 0; m < 4; ++m)
#pragma unroll
                for (int bj = 0; bj < 2; ++bj) {
                    const u32x4 a = ga[m][bj], b = gb[m][bj];
                    f32x4 r0, r1;
                    r0[0] = bflo(a.x) * __builtin_amdgcn_rcpf(bflo(b.x)); r0[1] = bfhi(a.x) * __builtin_amdgcn_rcpf(bfhi(b.x));
                    r0[2] = bflo(a.y) * __builtin_amdgcn_rcpf(bflo(b.y)); r0[3] = bfhi(a.y) * __builtin_amdgcn_rcpf(bfhi(b.y));
                    r1[0] = bflo(a.z) * __builtin_amdgcn_rcpf(bflo(b.z)); r1[1] = bfhi(a.z) * __builtin_amdgcn_rcpf(bfhi(b.z));
                    r1[2] = bflo(a.w) * __builtin_amdgcn_rcpf(bflo(b.w)); r1[3] = bfhi(a.w) * __builtin_amdgcn_rcpf(bfhi(b.w));
                    acc[ai][bj][m][0] *= r0; acc[ai][bj][m][1] *= r1;
                }
            asm volatile("" ::: "memory");
        }
    }
    __device__ __forceinline__ void operator()(const f32x4 (&acc)[2][2][4][2], const Unit& u, int wr, int wc, int fr, int fq) const {
        const int row0 = u.pm * BM + wr * 64 + fr, col0 = u.pn * BM + wc * 32 + fq * 8;
        const bf16_t* Gb = u.kind == 0 ? G + (size_t)row0 * NG + 2 * DM + col0 : G + (size_t)(MP + row0) * NG + (size_t)u.aux * DM + col0;
        bf16_t* Ob = u.kind == 0 ? O + (size_t)row0 * DM + col0 : PS + ((size_t)u.aux * 256 + row0) * DM + col0;
#pragma unroll
        for (int ai = 0; ai < 2; ++ai) {
            u32x4 gg[4][2];
#pragma unroll
            for (int m = 0; m < 4; ++m)
#pragma unroll
                for (int bj = 0; bj < 2; ++bj) gg[m][bj] = *(const u32x4*)(Gb + (size_t)(ai * HALF + m * 16) * NG + bj * HALF);
#pragma unroll
            for (int m = 0; m < 4; ++m) {
#pragma unroll
                for (int bj = 0; bj < 2; ++bj) {
                    const u32x4 g = gg[m][bj];
                    f32x4 v0 = acc[ai][bj][m][0], v1 = acc[ai][bj][m][1];
                    v0[0] *= bflo(g.x); v0[1] *= bfhi(g.x); v0[2] *= bflo(g.y); v0[3] *= bfhi(g.y); v1[0] *= bflo(g.z); v1[1] *= bfhi(g.z); v1[2] *= bflo(g.w); v1[3] *= bfhi(g.w);
                    *(u32x4*)(Ob + (size_t)(ai * HALF + m * 16) * DM + bj * HALF) = pack8(v0, v1);
                }
            }
            asm volatile("" ::: "memory");
        }
    }
};
struct EpiF32 {
    static constexpr bool PERM = true, HOOK = false;
    bf16_t* basep; float* part;
    __device__ __forceinline__ void operator()(const f32x4 (&acc)[2][2][4][2], const Unit& u, int wr, int wc, int fr, int fq) const {
        const int row0 = u.pm * BM + wr * 64 + fr, col0 = u.pn * BM + wc * 32 + fq * 8;
        if (u.kind == 0) {
#pragma unroll
            for (int ai = 0; ai < 2; ++ai)
#pragma unroll
                for (int m = 0; m < 4; ++m) {
                    bf16_t* p = basep + (size_t)(row0 + ai * HALF + m * 16) * DM;
#pragma unroll
                    for (int bj = 0; bj < 2; ++bj) *(u32x4*)(p + col0 + bj * HALF) = pack8(acc[ai][bj][m][0], acc[ai][bj][m][1]);
                }
        } else {
            float* base = part + (size_t)u.aux * 256 * DM;
#pragma unroll
            for (int ai = 0; ai < 2; ++ai)
#pragma unroll
                for (int m = 0; m < 4; ++m) {
                    float* p = base + (size_t)(row0 + ai * HALF + m * 16) * DM;
#pragma unroll
                    for (int bj = 0; bj < 2; ++bj) { const int col = col0 + bj * HALF; *(f32x4*)(p + col) = acc[ai][bj][m][0]; *(f32x4*)(p + col + 4) = acc[ai][bj][m][1]; }
                }
        }
    }
};
struct EpiSwiGLU {
    static constexpr bool PERM = true, HOOK = false;
    bf16_t* O;
    __device__ __forceinline__ void operator()(const f32x4 (&acc)[2][2][4][2], const Unit& u, int wr, int wc, int fr, int fq) const {
        const int row0 = u.pm * BM + wr * 64 + fr, col = u.pn * HALF + wc * 32 + fq * 8;
#pragma unroll
        for (int ai = 0; ai < 2; ++ai)
#pragma unroll
            for (int m = 0; m < 4; ++m) {
                const int row = row0 + ai * HALF + m * 16; f32x4 v0, v1;
#pragma unroll
                for (int e = 0; e < 4; ++e) { const float a0 = acc[ai][0][m][0][e], a1 = acc[ai][0][m][1][e]; v0[e] = a0 * sigmoidf_(a0) * acc[ai][1][m][0][e]; v1[e] = a1 * sigmoidf_(a1) * acc[ai][1][m][1][e]; }
                *(u32x4*)(O + (size_t)row * DFF + col) = pack8(v0, v1);
            }
    }
};
template <class Epi, class Sched, bool ALIGN_EPI = false, bool SP2 = false>
__device__ __forceinline__ void gemm_phase(PG8_LAS unsigned char* lds, const Gemm g, const Sched& S, const Epi& E) {
    int tid_l = threadIdx.x; asm volatile("" : "+v"(tid_l));
    const int tid = tid_l, wid = __builtin_amdgcn_readfirstlane(tid >> 6), lane = tid & 63, wr = wid >> 2, wc = wid & 3, fr = lane & 15, fq = lane >> 4;
    const int K = g.K;
    unsigned voffA[2], voffB[2];
#pragma unroll
    for (int i = 0; i < 2; ++i) { int R, C; stage_rc(tid * 16 + i * 8192, R, C); const int Rb = Epi::PERM ? ((R & ~31) + perm32(R & 31)) : R;
        voffA[i] = (unsigned)(R * K + C) * 2u; voffB[i] = (unsigned)(Rb * K + C) * 2u; }
    const size_t kstep = (size_t)(BK * 2);
    const size_t hstep = (size_t)HALF * K * 2;
    const size_t tstep = 2 * hstep;
    const unsigned ldsw = (unsigned)wid * 1024u;
    const int aoff = lds_byte(wr * 64 + fr, fq * 8), boff = lds_byte(wc * 32 + fr, fq * 8);
#define PG8_SA(b, h) (((b) * 2 + (h)) * HTB)
#define PG8_SB(b, h) ((4 + (b) * 2 + (h)) * HTB)
#define PG8_STAGE(bufoff, gbase, voff) do { _Pragma("unroll") for (int _i = 0; _i < 2; ++_i) \
        __builtin_amdgcn_global_load_lds((const unsigned*)((const char*)(gbase) + (voff)[_i]), (PG8_LAS unsigned*)(lds + (bufoff) + ldsw + _i * 8192), 16, 0, 0); } while (0)
#define PG8_LDA(dst, b, h) do { _Pragma("unroll") for (int m = 0; m < 4; ++m) _Pragma("unroll") for (int k = 0; k < 2; ++k) dst[m][k] = *(const PG8_LAS bf16x8*)(lds + PG8_SA(b, h) + aoff + m * 2048 + k * 1024); } while (0)
#define PG8_LDB(dst, b, h) do { _Pragma("unroll") for (int n = 0; n < 2; ++n) _Pragma("unroll") for (int k = 0; k < 2; ++k) dst[n][k] = *(const PG8_LAS bf16x8*)(lds + PG8_SB(b, h) + boff + n * 2048 + k * 1024); } while (0)
#define PG8_MMA(ai, bj, At, Bt) do { __builtin_amdgcn_s_setprio(1); _Pragma("unroll") for (int m = 0; m < 4; ++m) _Pragma("unroll") for (int n = 0; n < 2; ++n) _Pragma("unroll") for (int k = 0; k < 2; ++k) \
        acc[ai][bj][m][n] = __builtin_amdgcn_mfma_f32_16x16x32_bf16(Bt[n][k], At[m][k], acc[ai][bj][m][n], 0, 0, 0); __builtin_amdgcn_s_setprio(0); } while (0)
#define PG8_WAIT_V(n) asm volatile("s_waitcnt vmcnt(" #n ")" ::: "memory")
#define PG8_WAIT_L(n) asm volatile("s_waitcnt lgkmcnt(" #n ")" ::: "memory")
#define PG8_BAR __builtin_amdgcn_s_barrier()
#define PG8_SCHED __builtin_amdgcn_sched_barrier(0)
    Unit cur, nxt; int ui = 0;
    if (!S.next(0, cur)) return;
    f32x4 acc[2][2][4][2];
#pragma unroll
    for (int a = 0; a < 2; ++a)
#pragma unroll
        for (int b = 0; b < 2; ++b)
#pragma unroll
            for (int m = 0; m < 4; ++m)
#pragma unroll
                for (int n = 0; n < 2; ++n) acc[a][b][m][n] = (f32x4){0.f, 0.f, 0.f, 0.f};
    bf16x8 At[4][2], B0[2][2], B1[2][2];
    const char* cA = S.abase(cur, tstep); const char* cB = S.bbase(cur, tstep);
    S.a_ready(cur);
    if constexpr (SP2) {
        PG8_STAGE(PG8_SB(0, 0), cB, voffB); PG8_STAGE(PG8_SB(0, 1), cB + hstep, voffB); PG8_STAGE(PG8_SA(0, 0), cA, voffA); PG8_STAGE(PG8_SA(0, 1), cA + hstep, voffA);
        if (wr == 1) PG8_BAR;
        PG8_WAIT_V(2); PG8_BAR;
        PG8_STAGE(PG8_SB(1, 0), cB + kstep, voffB); PG8_STAGE(PG8_SA(1, 0), cA + kstep, voffA); PG8_STAGE(PG8_SB(1, 1), cB + hstep + kstep, voffB);
        PG8_WAIT_V(6); PG8_BAR;
    } else {
        PG8_STAGE(PG8_SB(0, 0), cB, voffB); PG8_STAGE(PG8_SA(0, 0), cA, voffA); PG8_STAGE(PG8_SB(0, 1), cB + hstep, voffB); PG8_STAGE(PG8_SA(0, 1), cA + hstep, voffA);
        if (wr == 1) PG8_BAR;
        PG8_WAIT_V(4); PG8_BAR;
        PG8_STAGE(PG8_SB(1, 0), cB + kstep, voffB); PG8_STAGE(PG8_SA(1, 0), cA + kstep, voffA); PG8_STAGE(PG8_SB(1, 1), cB + hstep + kstep, voffB);
        PG8_WAIT_V(6); PG8_BAR;
    }
    for (;;) {
        const bool has_next = S.next(ui + 1, nxt);
        const char* nA = has_next ? S.abase(nxt, tstep) : cA; const char* nB = has_next ? S.bbase(nxt, tstep) : cB;
        const int nt = S.nt(cur);
        for (int t = 0; t < nt; t += 2) {
            const bool last = (t == nt - 2);
            if constexpr (Epi::HOOK) { if (t == 16 || t == 32) E.hook(acc, cur, t >> 4, wr, wc, fr, fq); }
            const char* a1 = cA + (size_t)(t + 1) * kstep;
            const char* a2 = last ? nA : cA + (size_t)(t + 2) * kstep; const char* b2 = last ? nB : cB + (size_t)(t + 2) * kstep;
            const char* a3 = a2 + kstep; const char* b3 = b2 + kstep;
            if (last && has_next) S.a_ready(nxt);
            if constexpr (SP2) {
            PG8_LDB(B0, 0, 0); PG8_LDB(B1, 0, 1); PG8_SCHED; PG8_LDA(At, 0, 0); PG8_STAGE(PG8_SA(1, 1), a1 + hstep, voffA);
            PG8_WAIT_V(8); PG8_WAIT_L(0); PG8_BAR; PG8_MMA(0, 0, At, B0); PG8_MMA(0, 1, At, B1); PG8_BAR; PG8_SCHED;
            PG8_LDA(At, 0, 1); PG8_STAGE(PG8_SB(0, 0), b2, voffB); PG8_STAGE(PG8_SB(0, 1), b2 + hstep, voffB); PG8_STAGE(PG8_SA(0, 0), a2, voffA);
            PG8_WAIT_V(8); PG8_WAIT_L(0); PG8_BAR; PG8_MMA(1, 0, At, B0); PG8_MMA(1, 1, At, B1); PG8_BAR; PG8_SCHED;
            PG8_LDB(B0, 1, 0); PG8_LDB(B1, 1, 1); PG8_SCHED; PG8_LDA(At, 1, 0); PG8_STAGE(PG8_SA(0, 1), a2 + hstep, voffA);
            PG8_WAIT_V(8); PG8_WAIT_L(0); PG8_BAR; PG8_MMA(0, 0, At, B0); PG8_MMA(0, 1, At, B1); PG8_BAR; PG8_SCHED;
            PG8_LDA(At, 1, 1); PG8_STAGE(PG8_SB(1, 0), b3, voffB); PG8_STAGE(PG8_SB(1, 1), b3 + hstep, voffB); PG8_STAGE(PG8_SA(1, 0), a3, voffA);
            PG8_WAIT_V(8); PG8_WAIT_L(0); PG8_BAR; PG8_MMA(1, 0, At, B0); PG8_MMA(1, 1, At, B1); PG8_BAR; PG8_SCHED;
            } else {
            PG8_LDB(B0, 0, 0); PG8_SCHED; PG8_LDA(At, 0, 0); PG8_STAGE(PG8_SA(1, 1), a1 + hstep, voffA);
            PG8_WAIT_L(8); PG8_BAR; PG8_WAIT_L(0); PG8_MMA(0, 0, At, B0); PG8_BAR; PG8_SCHED;
            PG8_LDB(B1, 0, 1); PG8_STAGE(PG8_SB(0, 0), b2, voffB);
            PG8_BAR; PG8_WAIT_L(0); PG8_MMA(0, 1, At, B1); PG8_BAR;
            PG8_LDA(At, 0, 1); PG8_STAGE(PG8_SA(0, 0), a2, voffA);
            PG8_BAR; PG8_WAIT_L(0); PG8_MMA(1, 0, At, B0); PG8_BAR; PG8_SCHED;
            PG8_STAGE(PG8_SB(0, 1), b2 + hstep, voffB);
            PG8_WAIT_V(6); PG8_BAR; PG8_MMA(1, 1, At, B1); PG8_BAR;
            PG8_LDB(B0, 1, 0); PG8_SCHED; PG8_LDA(At, 1, 0); PG8_STAGE(PG8_SA(0, 1), a2 + hstep, voffA);
            PG8_WAIT_L(8); PG8_BAR; PG8_WAIT_L(0); PG8_MMA(0, 0, At, B0); PG8_BAR; PG8_SCHED;
            PG8_LDB(B1, 1, 1); PG8_STAGE(PG8_SB(1, 0), b3, voffB);
            PG8_BAR; PG8_WAIT_L(0); PG8_MMA(0, 1, At, B1); PG8_BAR;
            PG8_LDA(At, 1, 1); PG8_STAGE(PG8_SA(1, 0), a3, voffA);
            PG8_BAR; PG8_WAIT_L(0); PG8_MMA(1, 0, At, B0); PG8_BAR; PG8_SCHED;
            PG8_STAGE(PG8_SB(1, 1), b3 + hstep, voffB);
            PG8_WAIT_V(6); PG8_BAR; PG8_MMA(1, 1, At, B1); PG8_BAR;
            }
        }
        if constexpr (ALIGN_EPI) { if (wr == 0) PG8_BAR; }
        E(acc, cur, wr, wc, fr, fq);
        if (!has_next) break;
#pragma unroll
        for (int a = 0; a < 2; ++a)
#pragma unroll
            for (int b = 0; b < 2; ++b)
#pragma unroll
                for (int m = 0; m < 4; ++m)
#pragma unroll
                    for (int n = 0; n < 2; ++n) acc[a][b][m][n] = (f32x4){0.f, 0.f, 0.f, 0.f};
        cur = nxt; cA = nA; cB = nB; ++ui;
        if constexpr (ALIGN_EPI) { if (wr == 1) PG8_BAR; }
    }
    PG8_WAIT_V(0);
    if constexpr (!ALIGN_EPI) { if (wr == 0) PG8_BAR; }
    PG8_BAR;
#undef PG8_SA
#undef PG8_SB
#undef PG8_STAGE
#undef PG8_LDA
#undef PG8_LDB
#undef PG8_MMA
#undef PG8_WAIT_V
#undef PG8_WAIT_L
#undef PG8_BAR
#undef PG8_SCHED
}
}
namespace att {
typedef unsigned short bf16_t;
typedef short bf16x8 __attribute__((ext_vector_type(8)));
typedef short s16x4 __attribute__((ext_vector_type(4)));
typedef float f32x16 __attribute__((ext_vector_type(16)));
typedef unsigned u32x4 __attribute__((ext_vector_type(4)));
constexpr float NEG = -1e30f;
constexpr int WSF_OFF = 98304, TAB_OFF = WSF_OFF + 1024;
__device__ __forceinline__ int crow(int r, int h) { return (r & 3) + 8 * (r >> 2) + 4 * h; }
__device__ __forceinline__ s16x4 vtr(const LAS unsigned char* p) { return __builtin_bit_cast(s16x4, __builtin_amdgcn_ds_read_tr16_b64_v4i16((LAS s16x4*)p)); }
__device__ __forceinline__ unsigned short f2bf(float f) { unsigned u = __float_as_uint(f); return (unsigned short)((u + 0x7fffu + ((u >> 16) & 1u)) >> 16); }
__device__ __forceinline__ float bf2f(unsigned short b) { return __uint_as_float((unsigned)b << 16); }

__device__ __forceinline__ float xmax32(float m) {
    const auto rr = __builtin_amdgcn_permlane32_swap(__float_as_uint(m), __float_as_uint(m), false, false);
    return fmaxf(__uint_as_float(rr[0]), __uint_as_float(rr[1]));
}
__device__ __forceinline__ float xadd32(float v) {
    const auto rr = __builtin_amdgcn_permlane32_swap(__float_as_uint(v), __float_as_uint(v), false, false);
    return __uint_as_float(rr[0]) + __uint_as_float(rr[1]);
}
template <int NKS, int NB, int MODE, bool MASKK>
__device__ __forceinline__ void attn_pass(LAS unsigned char* lds, const bf16_t* qptr, int qpitch,
        const bf16_t* kb0, const bf16_t* vb0, int pitch0, const bf16_t* kb1, const bf16_t* vb1, int pitch1, int split,
        int t0, int t1, int wt0, int wt1, int qpos, int kpos0, float modc, int cwrel, int nkeys, f32x16 (&O)[4]) {
    constexpr int TK = 32 * NB, KP = NKS * 16 + 8, VP = 160;
    constexpr int KBYTES = TK * KP * 2, VBYTES = TK * VP * 2, STAGE = KBYTES + VBYTES;
    constexpr int KCPR = NKS * 2, KCH = TK * KCPR / 512, VCH = TK * 16 / 512;
    static_assert(KCH >= 1 && VCH >= 1 && 2 * STAGE <= WSF_OFF, "attention tile geometry");
    int tid_l = threadIdx.x; asm volatile("" : "+v"(tid_l));
    const int tid = tid_l, lane = tid & 63, r32 = lane & 31, h = lane >> 5;
    const int wid = __builtin_amdgcn_readfirstlane(tid >> 6);
    LAS float* wsf = (LAS float*)(lds + WSF_OFF) + wid * 32;
    const LAS float* tab = (const LAS float*)(lds + TAB_OFF);
#pragma unroll
    for (int db = 0; db < 4; ++db)
#pragma unroll
        for (int r = 0; r < 16; ++r) O[db][r] = 0.f;
    if (t1 <= t0) return;
    bf16x8 Q[NKS];
#pragma unroll
    for (int ks = 0; ks < NKS; ++ks) Q[ks] = *(const bf16x8*)(qptr + (size_t)r32 * qpitch + ks * 16 + 8 * h);
    float mhat = NEG, lsum = 0.f;
    u32x4 kreg[KCH], vreg[VCH];
#define ATT_LOAD(t) do { int tv_ = tid; asm volatile("" : "+v"(tv_)); const bool c0_ = (t) < split; const int pt_ = c0_ ? pitch0 : pitch1; \
        const bf16_t* kt_ = c0_ ? kb0 + (size_t)(t) * TK * pitch0 : kb1 + (size_t)((t) - split) * TK * pitch1; \
        const bf16_t* vt_ = c0_ ? vb0 + (size_t)(t) * TK * pitch0 : vb1 + (size_t)((t) - split) * TK * pitch1; \
        _Pragma("unroll") for (int j_ = 0; j_ < KCH; ++j_) { const int c_ = tv_ + j_ * 512; kreg[j_] = *(const u32x4*)(kt_ + (size_t)(c_ / KCPR) * pt_ + (c_ % KCPR) * 8); } \
        _Pragma("unroll") for (int j_ = 0; j_ < VCH; ++j_) { const int c_ = tv_ + j_ * 512; vreg[j_] = *(const u32x4*)(vt_ + (size_t)(c_ >> 4) * pt_ + (c_ & 15) * 8); } } while (0)
#define ATT_STORE(buf) do { int tv_ = tid; asm volatile("" : "+v"(tv_)); LAS unsigned char* sb_ = lds + (buf) * STAGE; \
        _Pragma("unroll") for (int j_ = 0; j_ < KCH; ++j_) { const int c_ = tv_ + j_ * 512; *(LAS u32x4*)(sb_ + ((c_ / KCPR) * KP + (c_ % KCPR) * 8) * 2) = kreg[j_]; } \
        _Pragma("unroll") for (int j_ = 0; j_ < VCH; ++j_) { const int c_ = tv_ + j_ * 512; *(LAS u32x4*)(sb_ + KBYTES + ((c_ >> 4) * VP + (c_ & 15) * 8) * 2) = vreg[j_]; } } while (0)
    ATT_LOAD(t0); ATT_STORE(0);
    __syncthreads();
    for (int t = t0; t < t1; ++t) {
        const int buf = (t - t0) & 1; const bool more = t + 1 < t1;
        if (more) ATT_LOAD(t + 1);
        if (t >= wt0 && t < wt1) {
            const LAS unsigned char* Kb = lds + buf * STAGE; const LAS unsigned char* Vb = Kb + KBYTES;
            int lv = lane; asm volatile("" : "+v"(lv));
            const int r32 = lv & 31, h = lv >> 5, q4 = (lv & 15) >> 2, p4 = lv & 3, bc = (lv >> 4) & 1;
            const LAS unsigned char* Kl = Kb + (r32 * KP + 8 * h) * 2;
            const LAS unsigned char* Vl = Vb + ((4 * h + q4) * VP + 16 * bc) * 2 + 8 * p4;
            f32x16 S[NB];
            bool uni = false; float ci = 0.f;
            if constexpr (MODE == 1) { uni = (t <= cwrel); ci = uni ? tab[0] : 0.f; }
            __builtin_amdgcn_s_setprio(1);
#pragma unroll
            for (int blk = 0; blk < NB; ++blk) {
#pragma unroll
                for (int r = 0; r < 16; ++r) S[blk][r] = ci;
#pragma unroll
                for (int ks = 0; ks < NKS; ++ks) {
                    const bf16x8 kf = *(const LAS bf16x8*)(Kl + (blk * 32 * KP + ks * 16) * 2);
                    S[blk] = __builtin_amdgcn_mfma_f32_32x32x16_bf16(kf, Q[ks], S[blk], 0, 0, 0);
                }
                __builtin_amdgcn_sched_barrier(0);
            }
            __builtin_amdgcn_s_setprio(0);
            if constexpr (MODE == 0) {
                const float kb = (float)(kpos0 + t * TK + 4 * h - qpos);
#pragma unroll
                for (int blk = 0; blk < NB; ++blk)
#pragma unroll
                    for (int r = 0; r < 16; ++r) { const float d = kb + (float)(blk * 32 + (r & 3) + 8 * (r >> 2)); S[blk][r] -= modc * __builtin_fabsf(d); }
            }
            if constexpr (MODE == 1) {
                if (!uni) {
                    const int kb = kpos0 + t * TK + 4 * h - qpos;
#pragma unroll
                    for (int blk = 0; blk < NB; ++blk)
#pragma unroll
                        for (int r = 0; r < 16; ++r) { int d = kb + blk * 32 + (r & 3) + 8 * (r >> 2); d = min(max(d, -128), 128) + 128; S[blk][r] += tab[d]; }
                }
            }
            if constexpr (MASKK) {
                const int kb = t * TK + 4 * h;
#pragma unroll
                for (int blk = 0; blk < NB; ++blk)
#pragma unroll
                    for (int r = 0; r < 16; ++r) if (kb + blk * 32 + (r & 3) + 8 * (r >> 2) >= nkeys) S[blk][r] = NEG;
            }
            float rm = S[0][0];
#pragma unroll
            for (int blk = 0; blk < NB; ++blk)
#pragma unroll
                for (int r = 0; r < 16; ++r) rm = fmaxf(rm, S[blk][r]);
            rm = xmax32(rm);
            __builtin_amdgcn_sched_barrier(0);
            if (__any(rm > mhat + 8.f)) {
                const float mnew = fmaxf(mhat, rm), al = __builtin_amdgcn_exp2f(mhat - mnew);
                mhat = mnew; lsum *= al; wsf[r32] = al;
#pragma unroll
                for (int r = 0; r < 16; ++r) { const float a = wsf[crow(r, h)];
#pragma unroll
                    for (int db = 0; db < 4; ++db) O[db][r] *= a; }
            }
#pragma unroll
            for (int blk = 0; blk < NB; ++blk)
#pragma unroll
                for (int r = 0; r < 16; ++r) { const float p = __builtin_amdgcn_exp2f(S[blk][r] - mhat); lsum += p; S[blk][r] = p; }
            __builtin_amdgcn_sched_barrier(0); __builtin_amdgcn_s_setprio(1);
#pragma unroll
            for (int blk = 0; blk < NB; ++blk)
#pragma unroll
                for (int s2 = 0; s2 < 2; ++s2) {
                    u32x4 pw; pw.x = pg8::cvt_pk_bf16(S[blk][8 * s2 + 0], S[blk][8 * s2 + 1]); pw.y = pg8::cvt_pk_bf16(S[blk][8 * s2 + 2], S[blk][8 * s2 + 3]);
                    pw.z = pg8::cvt_pk_bf16(S[blk][8 * s2 + 4], S[blk][8 * s2 + 5]); pw.w = pg8::cvt_pk_bf16(S[blk][8 * s2 + 6], S[blk][8 * s2 + 7]);
                    const bf16x8 pa = __builtin_bit_cast(bf16x8, pw);
#pragma unroll
                    for (int db = 0; db < 4; ++db) {
                        const LAS unsigned char* vp = Vl + ((32 * blk + 16 * s2) * VP + 32 * db) * 2;
                        const s16x4 lo = vtr(vp), hi = vtr(vp + 8 * VP * 2);
                        const bf16x8 vf = {lo[0], lo[1], lo[2], lo[3], hi[0], hi[1], hi[2], hi[3]};
                        O[db] = __builtin_amdgcn_mfma_f32_32x32x16_bf16(pa, vf, O[db], 0, 0, 0);
                    }
                    __builtin_amdgcn_sched_barrier(0);
                }
            __builtin_amdgcn_s_setprio(0);
        }
        if (more) ATT_STORE(buf ^ 1);
        __syncthreads();
    }
#undef ATT_LOAD
#undef ATT_STORE
    if (wt1 > wt0) {
        lsum = xadd32(lsum);
        wsf[r32] = 1.0f / lsum;
#pragma unroll
        for (int r = 0; r < 16; ++r) { const float a = wsf[crow(r, h)];
#pragma unroll
            for (int db = 0; db < 4; ++db) O[db][r] *= a; }
    }
}


template <int NKS, int NB, int MODE, bool MASKK>
__device__ __forceinline__ void attn_pass_pipe(LAS unsigned char* lds, const bf16_t* qptr, int qpitch,
        const bf16_t* kb0, const bf16_t* vb0, int pitch0, const bf16_t* kb1, const bf16_t* vb1, int pitch1, int split,
        int t0, int t1, int wt0, int wt1, int qpos, int kpos0, float modc, int cwrel, int nkeys, f32x16 (&O)[4]) {
    constexpr int TK = 32 * NB, KP = NKS * 16 + 8, VP = 160;
    constexpr int KBYTES = TK * KP * 2, VBYTES = TK * VP * 2;
    constexpr int KCPR = NKS * 2, KCH = TK * KCPR / 512, VCH = TK * 16 / 512;
    static_assert(KCH >= 1 && VCH >= 1 && 2 * (KBYTES + VBYTES) <= WSF_OFF, "attention tile geometry");
    int tid_l = threadIdx.x; asm volatile("" : "+v"(tid_l));
    const int tid = tid_l, lane = tid & 63, r32o = lane & 31, ho = lane >> 5;
    const int wid = __builtin_amdgcn_readfirstlane(tid >> 6);
    LAS float* wsf = (LAS float*)(lds + WSF_OFF) + wid * 32;
    const LAS float* tab = (const LAS float*)(lds + TAB_OFF);
#pragma unroll
    for (int db = 0; db < 4; ++db)
#pragma unroll
        for (int r = 0; r < 16; ++r) O[db][r] = 0.f;
    if (t1 <= t0) return;
    bf16x8 Q[NKS];
#pragma unroll
    for (int ks = 0; ks < NKS; ++ks) Q[ks] = *(const bf16x8*)(qptr + (size_t)r32o * qpitch + ks * 16 + 8 * ho);
    float mhat = NEG, lsum = 0.f;
    u32x4 krA[KCH], vrA[VCH], krB[KCH], vrB[VCH];
#define APP_LOADK(t, kreg) do { int tv_ = tid; asm volatile("" : "+v"(tv_)); const bool c0_ = (t) < split; const int pt_ = c0_ ? pitch0 : pitch1; \
        const bf16_t* kt_ = c0_ ? kb0 + (size_t)(t) * TK * pitch0 : kb1 + (size_t)((t) - split) * TK * pitch1; \
        _Pragma("unroll") for (int j_ = 0; j_ < KCH; ++j_) { const int c_ = tv_ + j_ * 512; kreg[j_] = *(const u32x4*)(kt_ + (size_t)(c_ / KCPR) * pt_ + (c_ % KCPR) * 8); } } while (0)
#define APP_LOADV(t, vreg) do { int tv_ = tid; asm volatile("" : "+v"(tv_)); const bool c0_ = (t) < split; const int pt_ = c0_ ? pitch0 : pitch1; \
        const bf16_t* vt_ = c0_ ? vb0 + (size_t)(t) * TK * pitch0 : vb1 + (size_t)((t) - split) * TK * pitch1; \
        _Pragma("unroll") for (int j_ = 0; j_ < VCH; ++j_) { const int c_ = tv_ + j_ * 512; vreg[j_] = *(const u32x4*)(vt_ + (size_t)(c_ >> 4) * pt_ + (c_ & 15) * 8); } } while (0)
#define APP_STOREK(p, kreg) do { int tv_ = tid; asm volatile("" : "+v"(tv_)); LAS unsigned char* sb_ = lds + (p) * KBYTES; \
        _Pragma("unroll") for (int j_ = 0; j_ < KCH; ++j_) { const int c_ = tv_ + j_ * 512; *(LAS u32x4*)(sb_ + ((c_ / KCPR) * KP + (c_ % KCPR) * 8) * 2) = kreg[j_]; } } while (0)
#define APP_STOREV(p, vreg) do { int tv_ = tid; asm volatile("" : "+v"(tv_)); LAS unsigned char* sb_ = lds + 2 * KBYTES + (p) * VBYTES; \
        _Pragma("unroll") for (int j_ = 0; j_ < VCH; ++j_) { const int c_ = tv_ + j_ * 512; *(LAS u32x4*)(sb_ + ((c_ >> 4) * VP + (c_ & 15) * 8) * 2) = vreg[j_]; } } while (0)
#define APP_QK(Sx, t_) do { const LAS unsigned char* Kb_ = lds + (((t_) - t0) & 1) * KBYTES; int lv_ = lane; asm volatile("" : "+v"(lv_)); \
        const LAS unsigned char* Kl_ = Kb_ + ((lv_ & 31) * KP + 8 * (lv_ >> 5)) * 2; float ci_ = 0.f; if constexpr (MODE == 1) { ci_ = ((t_) <= cwrel) ? tab[0] : 0.f; } \
        __builtin_amdgcn_s_setprio(1); \
        _Pragma("unroll") for (int blk = 0; blk < NB; ++blk) { _Pragma("unroll") for (int r = 0; r < 16; ++r) Sx[blk][r] = ci_; \
            _Pragma("unroll") for (int ks = 0; ks < NKS; ++ks) { const bf16x8 kf_ = *(const LAS bf16x8*)(Kl_ + (blk * 32 * KP + ks * 16) * 2); Sx[blk] = __builtin_amdgcn_mfma_f32_32x32x16_bf16(kf_, Q[ks], Sx[blk], 0, 0, 0); } } \
        __builtin_amdgcn_s_setprio(0); } while (0)
#define APP_SMPV(Sx, t_) do { const LAS unsigned char* Vb_ = lds + 2 * KBYTES + (((t_) - t0) & 1) * VBYTES; int lv_ = lane; asm volatile("" : "+v"(lv_)); \
        const int r32 = lv_ & 31, h = lv_ >> 5, q4 = (lv_ & 15) >> 2, p4 = lv_ & 3, bc = (lv_ >> 4) & 1; \
        const LAS unsigned char* Vl = Vb_ + ((4 * h + q4) * VP + 16 * bc) * 2 + 8 * p4; \
        if constexpr (MODE == 0) { const float kb = (float)(kpos0 + (t_) * TK + 4 * h - qpos); \
            _Pragma("unroll") for (int blk = 0; blk < NB; ++blk) _Pragma("unroll") for (int r = 0; r < 16; ++r) { const float d = kb + (float)(blk * 32 + (r & 3) + 8 * (r >> 2)); Sx[blk][r] -= modc * __builtin_fabsf(d); } } \
        if constexpr (MODE == 1) { if (!((t_) <= cwrel)) { const int kb = kpos0 + (t_) * TK + 4 * h - qpos; \
            _Pragma("unroll") for (int blk = 0; blk < NB; ++blk) _Pragma("unroll") for (int r = 0; r < 16; ++r) { int d = kb + blk * 32 + (r & 3) + 8 * (r >> 2); d = min(max(d, -128), 128) + 128; Sx[blk][r] += tab[d]; } } } \
        if constexpr (MASKK) { const int kb = (t_) * TK + 4 * h; \
            _Pragma("unroll") for (int blk = 0; blk < NB; ++blk) _Pragma("unroll") for (int r = 0; r < 16; ++r) if (kb + blk * 32 + (r & 3) + 8 * (r >> 2) >= nkeys) Sx[blk][r] = NEG; } \
        float rm = Sx[0][0]; \
        _Pragma("unroll") for (int blk = 0; blk < NB; ++blk) _Pragma("unroll") for (int r = 0; r < 16; ++r) rm = fmaxf(rm, Sx[blk][r]); \
        rm = xmax32(rm); \
        if (__any(rm > mhat + 8.f)) { const float mnew = fmaxf(mhat, rm), al = __builtin_amdgcn_exp2f(mhat - mnew); mhat = mnew; lsum *= al; wsf[r32] = al; \
            _Pragma("unroll") for (int r = 0; r < 16; ++r) { const float a_ = wsf[crow(r, h)]; _Pragma("unroll") for (int db = 0; db < 4; ++db) O[db][r] *= a_; } } \
        _Pragma("unroll") for (int blk = 0; blk < NB; ++blk) _Pragma("unroll") for (int r = 0; r < 16; ++r) { const float p = __builtin_amdgcn_exp2f(Sx[blk][r] - mhat); lsum += p; Sx[blk][r] = p; } \
        __builtin_amdgcn_sched_barrier(0); __builtin_amdgcn_s_setprio(1); \
        _Pragma("unroll") for (int blk = 0; blk < NB; ++blk) _Pragma("unroll") for (int s2 = 0; s2 < 2; ++s2) { \
            u32x4 pw; pw.x = pg8::cvt_pk_bf16(Sx[blk][8 * s2 + 0], Sx[blk][8 * s2 + 1]); pw.y = pg8::cvt_pk_bf16(Sx[blk][8 * s2 + 2], Sx[blk][8 * s2 + 3]); \
            pw.z = pg8::cvt_pk_bf16(Sx[blk][8 * s2 + 4], Sx[blk][8 * s2 + 5]); pw.w = pg8::cvt_pk_bf16(Sx[blk][8 * s2 + 6], Sx[blk][8 * s2 + 7]); \
            const bf16x8 pa = __builtin_bit_cast(bf16x8, pw); \
            _Pragma("unroll") for (int db = 0; db < 4; ++db) { const LAS unsigned char* vp = Vl + ((32 * blk + 16 * s2) * VP + 32 * db) * 2; \
                const s16x4 lo = vtr(vp), hi = vtr(vp + 8 * VP * 2); const bf16x8 vf = {lo[0], lo[1], lo[2], lo[3], hi[0], hi[1], hi[2], hi[3]}; \
                O[db] = __builtin_amdgcn_mfma_f32_32x32x16_bf16(pa, vf, O[db], 0, 0, 0); } \
            __builtin_amdgcn_sched_barrier(0); } __builtin_amdgcn_s_setprio(0); } while (0)
#define APP_STEP(Sc, Sn, t_, KL, VL, KS, VS) do { \
        if ((t_) + 3 < t1) APP_LOADK((t_) + 3, KL); if ((t_) + 2 < t1) APP_LOADV((t_) + 2, VL); \
        if ((t_) + 1 >= wt0 && (t_) + 1 < wt1) APP_QK(Sn, (t_) + 1); \
        __builtin_amdgcn_sched_barrier(0); \
        if ((t_) >= wt0 && (t_) < wt1) APP_SMPV(Sc, t_); \
        if ((t_) + 2 < t1) APP_STOREK(((t_) - t0) & 1, KS); if ((t_) + 1 < t1) APP_STOREV((((t_) - t0) + 1) & 1, VS); \
        __syncthreads(); } while (0)
    f32x16 Sa[NB], Sb[NB];
    APP_LOADK(t0, krA); APP_LOADV(t0, vrA); APP_STOREK(0, krA); APP_STOREV(0, vrA);
    if (t0 + 1 < t1) { APP_LOADK(t0 + 1, krA); APP_STOREK(1, krA); }
    if (t0 + 2 < t1) APP_LOADK(t0 + 2, krB); if (t0 + 1 < t1) APP_LOADV(t0 + 1, vrB);
    __syncthreads();
    if (t0 >= wt0 && t0 < wt1) APP_QK(Sa, t0);
    __syncthreads();
    for (int t = t0; t < t1;) {
        APP_STEP(Sa, Sb, t, krA, vrA, krB, vrB); ++t; if (t >= t1) break;
        APP_STEP(Sb, Sa, t, krB, vrB, krA, vrA); ++t;
    }
#undef APP_LOADK
#undef APP_LOADV
#undef APP_STOREK
#undef APP_STOREV
#undef APP_QK
#undef APP_SMPV
#undef APP_STEP
    if (wt1 > wt0) {
        lsum = xadd32(lsum);
        wsf[r32o] = 1.0f / lsum;
#pragma unroll
        for (int r = 0; r < 16; ++r) { const float a = wsf[crow(r, ho)];
#pragma unroll
            for (int db = 0; db < 4; ++db) O[db][r] *= a; }
    }
}

struct Ptrs {
    const bf16_t* QKV; bf16_t* OB; const bf16_t *MKp, *MVp, *KAc, *VAc, *KBc, *VBc, *MKc, *MVc;
    const float *relb, *subln; float lam;
};
__device__ __forceinline__ void store_o(const f32x16 (&O)[4], bf16_t* dst, int nrows, int lane) {
    const int r32 = lane & 31, h = lane >> 5;
    const unsigned lo = (unsigned)((4 * h * 3072 + r32) * 2);
#pragma unroll
    for (int r = 0; r < 16; ++r) { const int row = crow(r, h);
        unsigned o = lo + (unsigned)(((r & 3) + 8 * (r >> 2)) * 6144); asm volatile("" : "+v"(o));
        unsigned char* p = (unsigned char*)dst + o;
        if (row < nrows) {
#pragma unroll
            for (int db = 0; db < 4; ++db) *(bf16_t*)(p + 64 * db) = f2bf(O[db][r]); } }
}
template <bool SAMPLE> __device__ __forceinline__ void unit_a(LAS unsigned char* lds, const Ptrs& P, int b, int head, int qb) {
    int tid_l = threadIdx.x; asm volatile("" : "+v"(tid_l));
    const int tid = tid_l, lane = tid & 63, r32 = lane & 31, h = lane >> 5, wid = __builtin_amdgcn_readfirstlane(tid >> 6);
    const size_t rowbase = SAMPLE ? (size_t)MP + b * 16 : (size_t)b * 2048 + qb * 256 + wid * 32;
    const float modc = __builtin_amdgcn_exp2f(-(float)(head + 1)) * LOG2E;
    const bool active = SAMPLE ? (wid == 0) : true;
    const int nrows = SAMPLE ? 16 : 32;
    bf16_t* ob = P.OB + rowbase * 3072 + head * 128;
    f32x16 O[4];
#pragma unroll 1
    for (int map = 0; map < 2; ++map) {
        const bf16_t* qptr = P.QKV + rowbase * NQKV + head * 128 + map * 64;
        if constexpr (SAMPLE) {
            const bf16_t* kb0 = P.KAc + (size_t)b * 1024 * 1024 + head * 128 + map * 64; const bf16_t* vb0 = P.VAc + (size_t)b * 1024 * 1024 + head * 128;
            const bf16_t* kb1 = P.QKV + rowbase * NQKV + 1024 + head * 128 + map * 64; const bf16_t* vb1 = P.QKV + rowbase * NQKV + 2048 + head * 128;
            attn_pass<4, 2, 0, true>(lds, qptr, NQKV, kb0, vb0, 1024, kb1, vb1, NQKV, 16, 0, 17, 0, active ? 17 : 0, 1024 + r32, 0, modc, 0, 1040, O);
        } else {
            const bf16_t* kb0 = P.QKV + (size_t)b * 2048 * NQKV + 1024 + head * 128 + map * 64; const bf16_t* vb0 = P.QKV + (size_t)b * 2048 * NQKV + 2048 + head * 128;
            attn_pass_pipe<4, 2, 0, false>(lds, qptr, NQKV, kb0, vb0, NQKV, kb0, vb0, NQKV, 1 << 30, 0, 4 * qb + 4, 0, 4 * qb + (wid >> 1) + 1, qb * 256 + wid * 32 + r32, 0, modc, 0, 0, O);
        }
        if (active) {
            if (map == 0) store_o(O, ob, nrows, lane);
            else {
                float gs[4];
#pragma unroll
                for (int db = 0; db < 4; ++db) gs[db] = P.subln[32 * db + r32] * 0.8f;
                const unsigned lo = (unsigned)((4 * h * 3072 + r32) * 2);
#pragma unroll
                for (int r = 0; r < 16; ++r) { const int row = crow(r, h); float ss = 0.f;
                    unsigned o = lo + (unsigned)(((r & 3) + 8 * (r >> 2)) * 6144); asm volatile("" : "+v"(o));
                    unsigned char* p = (unsigned char*)ob + o;
                    if (row < nrows) {
#pragma unroll
                        for (int db = 0; db < 4; ++db) { const float ov = bf2f(*(const bf16_t*)(p + 64 * db)) - P.lam * O[db][r]; O[db][r] = ov; ss += ov * ov; } }
#pragma unroll
                    for (int o_ = 1; o_ < 32; o_ <<= 1) ss += __shfl_xor(ss, o_);
                    const float rn = rsqrtf(ss * (1.0f / 128.0f) + EPS);
                    if (row < nrows) {
#pragma unroll
                        for (int db = 0; db < 4; ++db) *(bf16_t*)(p + 64 * db) = f2bf(O[db][r] * rn * gs[db]); }
                    asm volatile("" ::: "memory"); }
            }
        }
    }
}
template <bool SAMPLE> __device__ __forceinline__ void unit_b(LAS unsigned char* lds, const Ptrs& P, int b, int head, int qb) {
    int tid_l = threadIdx.x; asm volatile("" : "+v"(tid_l));
    const int tid = tid_l, lane = tid & 63, r32 = lane & 31, wid = __builtin_amdgcn_readfirstlane(tid >> 6);
    const size_t rowbase = SAMPLE ? (size_t)MP + b * 16 : (size_t)b * 2048 + qb * 256 + wid * 32;
    LAS float* tab = (LAS float*)(lds + TAB_OFF);
    if (tid < 257) tab[tid] = P.relb[head * 257 + tid] * LOG2E;
    const bf16_t* qptr = P.QKV + rowbase * NQKV + 3072 + head * 128;
    f32x16 O[4];
    if constexpr (SAMPLE) {
        const bool active = wid == 0;
        const bf16_t* kb0 = P.KBc + (size_t)b * 512 * 1024 + head * 128; const bf16_t* vb0 = P.VBc + (size_t)b * 512 * 1024 + head * 128;
        const bf16_t* kb1 = P.QKV + rowbase * NQKV + 4096 + head * 128; const bf16_t* vb1 = P.QKV + rowbase * NQKV + 5120 + head * 128;
        attn_pass<8, 2, 1, true>(lds, qptr, NQKV, kb0, vb0, 1024, kb1, vb1, NQKV, 8, 0, 9, 0, active ? 9 : 0, 1024 + r32, 512, 0.f, 5, 528, O);
        if (active) store_o(O, P.OB + rowbase * 3072 + 1024 + head * 128, 16, lane);
    } else {
        const int c0 = 4 * qb, cw = c0 + (wid >> 1);
        const bf16_t* kb0 = P.QKV + (size_t)b * 2048 * NQKV + 4096 + head * 128; const bf16_t* vb0 = P.QKV + (size_t)b * 2048 * NQKV + 5120 + head * 128;
        attn_pass<8, 2, 1, false>(lds, qptr, NQKV, kb0, vb0, NQKV, kb0, vb0, NQKV, 1 << 30, max(0, c0 - 8), c0 + 4, max(0, cw - 8), cw + 1, qb * 256 + wid * 32 + r32, 0, 0.f, cw - 3, 0, O);
        store_o(O, P.OB + rowbase * 3072 + 1024 + head * 128, 32, lane);
    }
}
template <bool SAMPLE> __device__ __forceinline__ void unit_c(LAS unsigned char* lds, const Ptrs& P, int b, int head, int qb) {
    int tid_l = threadIdx.x; asm volatile("" : "+v"(tid_l));
    const int tid = tid_l, lane = tid & 63, wid = __builtin_amdgcn_readfirstlane(tid >> 6);
    const size_t rowbase = SAMPLE ? (size_t)MP + b * 16 : (size_t)b * 2048 + qb * 256 + wid * 32;
    const bool active = SAMPLE ? (wid == 0) : true;
    const bf16_t* qptr = P.QKV + rowbase * NQKV + 6144 + head * 256;
    const bf16_t* kb = (SAMPLE ? P.MKc : P.MKp) + (size_t)b * 256 * 1024 + head * 256;
    const bf16_t* vb = (SAMPLE ? P.MVc : P.MVp) + (size_t)b * 256 * 1024 + head * 256;
    f32x16 O[4];
#pragma unroll 1
    for (int dh = 0; dh < 2; ++dh) {
        attn_pass<16, 1, 2, false>(lds, qptr, NQKV, kb, vb + dh * 128, 1024, kb, vb + dh * 128, 1024, 1 << 30, 0, 8, 0, active ? 8 : 0, 0, 0, 0.f, 0, 0, O);
        if (active) store_o(O, P.OB + rowbase * 3072 + 2048 + head * 256 + dh * 128, SAMPLE ? 16 : 32, lane);
    }
}
}
typedef unsigned short bf16;
typedef unsigned v4u __attribute__((ext_vector_type(4)));
typedef unsigned v2u __attribute__((ext_vector_type(2)));
typedef float f32x4 __attribute__((ext_vector_type(4)));
constexpr int NWAVES = 8;
#ifndef REP_P0
#define REP_P0 1
#endif
#ifndef REP_P5
#define REP_P5 1
#endif
#ifndef REP_A
#define REP_A 1
#endif
#ifndef REP_G1
#define REP_G1 1
#endif
#ifndef REP_G3
#define REP_G3 1
#endif
#ifndef REP_G4
#define REP_G4 1
#endif
#ifndef REP_G6
#define REP_G6 1
#endif
#ifndef REP_G7
#define REP_G7 1
#endif
#ifndef REP_P2
#define REP_P2 1
#endif
constexpr int LDS_BYTES = 147456;
#define LDS_WAIT() asm volatile("s_waitcnt lgkmcnt(0)" ::: "memory")
__device__ __forceinline__ unsigned pk2(float lo, float hi) { return pg8::cvt_pk_bf16(lo, hi); }
__device__ __forceinline__ float wave_sum(float v) {
#pragma unroll
    for (int o = 1; o < 64; o <<= 1) v += __shfl_xor(v, o);
    return v;
}
__device__ __forceinline__ void transpose_item(const float* W, int N, bf16* WT, int dpitch, int koff, int mode, LAS float* scr, int item, int lane) {
    const int nblk = N / 64, kb = item / nblk, nb = item % nblk, k0 = 64 * kb, n0 = 64 * nb;
    int d0 = n0;
    if (mode == 1) { const int isb = n0 >= DFF, n1 = isb ? n0 - DFF : n0; d0 = (n1 >> 7) * 256 + (n1 & 127) + (isb ? 128 : 0); }
    f32x4 v[16]; const int kr = lane >> 4, nn = (lane & 15) * 4;
    const float* wp = W + (size_t)(k0 + kr) * N + n0 + nn;
#pragma unroll
    for (int i = 0; i < 16; ++i) v[i] = __builtin_nontemporal_load((const f32x4*)(wp + (size_t)(4 * i) * N));
#pragma unroll
    for (int i = 0; i < 16; ++i) { LAS float* s = scr + (4 * i + kr) * 65 + nn; s[0] = v[i].x; s[1] = v[i].y; s[2] = v[i].z; s[3] = v[i].w; }
    LDS_WAIT(); asm volatile("" ::: "memory");
    const int c = lane & 7;
#pragma unroll
    for (int j = 0; j < 8; ++j) { const int n = (lane >> 3) + 8 * j; const LAS float* s = scr + (8 * c) * 65 + n;
        v4u o; o.x = pk2(s[0 * 65], s[1 * 65]); o.y = pk2(s[2 * 65], s[3 * 65]); o.z = pk2(s[4 * 65], s[5 * 65]); o.w = pk2(s[6 * 65], s[7 * 65]);
        *(v4u*)(WT + (size_t)(d0 + n) * dpitch + koff + k0 + 8 * c) = o; }
    LDS_WAIT(); asm volatile("" ::: "memory");
}
__device__ __forceinline__ void rms_rows_to_bf16(const float* src, const float* g, bf16* dst, int nrows, int w0, int nw, int lane) {
    f32x4 gg[8]; { const f32x4* gr = (const f32x4*)g + lane;
#pragma unroll
        for (int j = 0; j < 8; ++j) gg[j] = gr[64 * j]; }
    f32x4 va[8], vb[8];
#define RMS_LOAD(m_, V) do { const f32x4* xr_ = (const f32x4*)(src + (size_t)(m_) * DM) + lane; _Pragma("unroll") for (int j = 0; j < 8; ++j) V[j] = __builtin_nontemporal_load(xr_ + 64 * j); } while (0)
#define RMS_PROC(m_, V) do { float s_ = 0.f; _Pragma("unroll") for (int j = 0; j < 8; ++j) s_ += (V[j].x * V[j].x + V[j].y * V[j].y) + (V[j].z * V[j].z + V[j].w * V[j].w); \
        const float rs_ = rsqrtf(wave_sum(s_) * (1.f / DM) + EPS); v2u* o8_ = (v2u*)(dst + (size_t)(m_) * DM) + lane; \
        _Pragma("unroll") for (int j = 0; j < 8; ++j) { v2u w_; w_.x = pk2(V[j].x * rs_ * gg[j].x, V[j].y * rs_ * gg[j].y); w_.y = pk2(V[j].z * rs_ * gg[j].z, V[j].w * rs_ * gg[j].w); o8_[64 * j] = w_; } } while (0)
    int m = w0; if (m < nrows) RMS_LOAD(m, va);
    while (m < nrows) {
        if (m + nw < nrows) RMS_LOAD(m + nw, vb);
        __builtin_amdgcn_sched_barrier(0);
        RMS_PROC(m, va); m += nw; if (m >= nrows) break;
        if (m + nw < nrows) RMS_LOAD(m + nw, va);
        __builtin_amdgcn_sched_barrier(0);
        RMS_PROC(m, vb); m += nw;
    }
#undef RMS_LOAD
#undef RMS_PROC
}
__device__ __forceinline__ void zero_row_bf16(bf16* orow, int lane) { v2u* o8 = (v2u*)orow + lane; v2u z; z.x = 0u; z.y = 0u;
#pragma unroll
    for (int j = 0; j < 8; ++j) o8[64 * j] = z; }
__device__ __forceinline__ void cvt_f32_bf16(const float* src, bf16* dst, size_t n, size_t gt, size_t ngt) {
    for (size_t i = gt * 8; i < n; i += ngt * 32) {
        f32x4 a[4], b[4];
#pragma unroll
        for (int u = 0; u < 4; ++u) { const size_t k = i + (size_t)u * ngt * 8; if (k < n) { a[u] = __builtin_nontemporal_load((const f32x4*)(src + k)); b[u] = __builtin_nontemporal_load((const f32x4*)(src + k + 4)); } }
#pragma unroll
        for (int u = 0; u < 4; ++u) { const size_t k = i + (size_t)u * ngt * 8; if (k < n) { v4u o; o.x = pk2(a[u].x, a[u].y); o.y = pk2(a[u].z, a[u].w); o.z = pk2(b[u].x, b[u].y); o.w = pk2(b[u].z, b[u].w); *(v4u*)(dst + k) = o; } }
    }
}
__device__ __forceinline__ f32x4 unpk4(v2u w) { f32x4 r; r.x = __uint_as_float(w.x << 16); r.y = __uint_as_float(w.x & 0xffff0000u); r.z = __uint_as_float(w.y << 16); r.w = __uint_as_float(w.y & 0xffff0000u); return r; }
#define RLX_AGENT __ATOMIC_RELAXED, __HIP_MEMORY_SCOPE_AGENT
#define XB_TMO      128
#define XB_XCNT(j)  (256  + 64 * (j))
#define XB_XSUB(j)  (1280 + 64 * (j))
#define XB_XGEN(j)  (2304 + 64 * (j))
#define XB_TOP      3328
#define XB_TOPGEN   3392
#define XCD_BAR_WORDS 3456
#define XB_SPIN_CAP (1u << 18)

__device__ __forceinline__ unsigned xb_ld(unsigned* p)              { return __hip_atomic_load(p, __ATOMIC_RELAXED, __HIP_MEMORY_SCOPE_AGENT); }
__device__ __forceinline__ unsigned xb_add(unsigned* p, unsigned v) { return __hip_atomic_fetch_add(p, v, __ATOMIC_RELAXED, __HIP_MEMORY_SCOPE_AGENT); }
__device__ __forceinline__ unsigned xb_xcc_id() { return (unsigned)__builtin_amdgcn_s_getreg((3 << 11) | 20) & 0xFu; }
#define XB_SPIN(cond, bar) do { unsigned _sp = 0; while (cond) { __builtin_amdgcn_s_sleep(1); \
    if ((++_sp & 255u) == 0u) { if (xb_ld(&(bar)[XB_TMO])) break; if (_sp > XB_SPIN_CAP) { atomicAdd(&(bar)[XB_TMO], 1u); break; } } } } while (0)

struct XcdBarrier {
    unsigned* bar; unsigned x;
    volatile LAS unsigned* st;
};

__device__ __forceinline__ XcdBarrier xcd_barrier_post(unsigned* bar, volatile LAS unsigned* st) {
    XcdBarrier b; b.bar = bar; b.x = xb_xcc_id(); b.st = st;
    if (threadIdx.x == 0) (void)xb_add(&bar[XB_XCNT(b.x)], 1u);
    return b;
}
__device__ __forceinline__ void xcd_barrier_complete(unsigned* bar, unsigned x, unsigned& nloc, unsigned& nx) {
    const unsigned G = gridDim.x * gridDim.y * gridDim.z;
    unsigned sum, cnt, mine, sp = 0u;
    for (;;) {
        sum = 0u; cnt = 0u; mine = 0u;
#pragma unroll
        for (unsigned j = 0; j < 16; ++j) { const unsigned c = xb_ld(&bar[XB_XCNT(j)]); sum += c; cnt += (c > 0u) ? 1u : 0u; mine = (j == x) ? c : mine; }
        if (sum == G) break;
        __builtin_amdgcn_s_sleep(1);
        if ((++sp & 255u) == 0u) { if (xb_ld(&bar[XB_TMO])) break; if (sp > XB_SPIN_CAP) { atomicAdd(&bar[XB_TMO], 1u); break; } }
    }
    nloc = mine > 0u ? mine : 1u; nx = cnt > 0u ? cnt : 1u;
}

__device__ __forceinline__ void xcd_barrier(const XcdBarrier& b) {
    asm volatile("s_waitcnt vmcnt(0)" ::: "memory");
    __syncthreads();
    if (threadIdx.x == 0) {
        unsigned* bar = b.bar;
        __builtin_amdgcn_s_waitcnt(0);
        unsigned nloc = b.st[0], nx = b.st[1];
        if (nloc == 0u) { xcd_barrier_complete(bar, b.x, nloc, nx); b.st[0] = nloc; b.st[1] = nx; }
        const unsigned old = xb_add(&bar[XB_XSUB(b.x)], 1u);
        const unsigned gen = old / nloc;
        if (old + 1u == (gen + 1u) * nloc) {
            __builtin_amdgcn_fence(__ATOMIC_RELEASE, "agent");
            asm volatile("s_waitcnt vmcnt(0)" ::: "memory");
            const unsigned og = xb_add(&bar[XB_TOP], 1u);
            const unsigned tg = og / nx;
            if (og + 1u == (tg + 1u) * nx) xb_add(&bar[XB_TOPGEN], 1u);
            else XB_SPIN(xb_ld(&bar[XB_TOPGEN]) == tg, bar);
            __builtin_amdgcn_fence(__ATOMIC_ACQUIRE, "agent");
            xb_add(&bar[XB_XGEN(b.x)], 1u);
            asm volatile("s_waitcnt vmcnt(0)" ::: "memory");
        } else {
            XB_SPIN(xb_ld(&bar[XB_XGEN(b.x)]) == gen, bar);
            __builtin_amdgcn_fence(__ATOMIC_ACQUIRE, "agent");
            asm volatile("s_waitcnt vmcnt(0)" ::: "memory");
        }
    }
    __syncthreads();
}

struct Args { const float* in[29]; float* out; unsigned char* ws; };
enum { I_XP = 0, I_XS, I_CAK, I_CAV, I_CBK, I_CBV, I_CMK, I_CMV, I_MEM, I_NMIXPRE, I_NMIXPOST, I_NMEM, I_WIN, I_BGATE, I_LQ1, I_LK1, I_LQ2, I_LK2, I_SUBLN, I_RELB,
       I_WMEM, I_WBRA, I_WBRB, I_WBRC, I_WOUT, I_NFFPRE, I_NFFPOST, I_WFFI, I_WFFO };

__global__ void __launch_bounds__(NWAVES * 64, 2) fwd_megakernel(Args a) {
    extern __shared__ __attribute__((aligned(16))) unsigned char lds_raw[];
    cg::grid_group grid = cg::this_grid();
    LAS unsigned char* lds = (LAS unsigned char*)lds_raw;
#define FRESH_TID() int tid_l = threadIdx.x; asm volatile("" : "+v"(tid_l)); const int tid = tid_l, lane = tid & 63; (void)lane;
    const int wave = __builtin_amdgcn_readfirstlane((int)threadIdx.x >> 6);
    const int G = gridDim.x, bx = blockIdx.x, vcu = (G % 8 == 0) ? (bx % 8) * (G / 8) + bx / 8 : bx;
    unsigned char* ws = a.ws; unsigned char* ys = (unsigned char*)a.out;
    bf16* Win_t = (bf16*)(ws + WS_WIN); bf16* Wmem_t = (bf16*)(ws + WS_WMEM); bf16* Wbr_t = (bf16*)(ws + WS_WBR); bf16* Wout_t = (bf16*)(ws + WS_WOUT);
    bf16* Wffi_t = (bf16*)(ws + WS_WFFI); bf16* Wffo_t = (bf16*)(ws + WS_WFFO);
    bf16* QKV = (bf16*)(ws + WS_QKV); bf16* GT = (bf16*)(ws + WS_G); bf16* MEMN = (bf16*)(ws + WS_MEMN); bf16* MKp = (bf16*)(ws + WS_MKP); bf16* MVp = (bf16*)(ws + WS_MVP);
    bf16* MERGED = (bf16*)(ws + WS_MERGED); bf16* T = (bf16*)(ws + WS_T); bf16* ACT = (bf16*)(ws + WS_ACT); bf16* X1 = (bf16*)(ws + WS_X1); bf16* UB = (bf16*)(ws + WS_H2);       bf16* H2 = (bf16*)(ws + WS_H2);
    bf16* PSB = (bf16*)(ws + WS_PS); float* TS = (float*)(ws + WS_TS); float* US = (float*)(ws + WS_US);
    bf16* XN = (bf16*)(ys + YS_XN); bf16* OB = (bf16*)(ys + YS_OB);
    bf16* KAc = (bf16*)(ys + YS_KAC); bf16* VAc = (bf16*)(ys + YS_VAC); bf16* KBc = (bf16*)(ys + YS_KBC); bf16* VBc = (bf16*)(ys + YS_VBC); bf16* MKc = (bf16*)(ys + YS_MKC); bf16* MVc = (bf16*)(ys + YS_MVC);
    const int gw = vcu * NWAVES + wave, NGW = G * NWAVES;
    volatile LAS unsigned* bst = (volatile LAS unsigned*)(lds + 147392);
    if (threadIdx.x < 2) bst[threadIdx.x] = 0u;
    __syncthreads();
    const XcdBarrier xbar = xcd_barrier_post((unsigned*)(ws + WS_CTL), bst);
    unsigned* xrank = (unsigned*)(ws + WS_CTL) + 3584;
    if (threadIdx.x == 0) bst[2] = __hip_atomic_fetch_add(xrank + 16 * xbar.x, 1u, __ATOMIC_RELAXED, __HIP_MEMORY_SCOPE_AGENT);
    __syncthreads();

#pragma unroll 1
    for (int rep0 = 0; rep0 < REP_P0; ++rep0) {
        FRESH_TID();
        LAS float* scr = (LAS float*)(lds + wave * 16640);
        const size_t gt = (size_t)vcu * 512 + tid, ngt = (size_t)G * 512;
        cvt_f32_bf16(a.in[I_CAK], KAc, 8388608, gt, ngt); cvt_f32_bf16(a.in[I_CAV], VAc, 8388608, gt, ngt);
        cvt_f32_bf16(a.in[I_CBK], KBc, 4194304, gt, ngt); cvt_f32_bf16(a.in[I_CBV], VBc, 4194304, gt, ngt);
        cvt_f32_bf16(a.in[I_CMK], MKc, 2097152, gt, ngt); cvt_f32_bf16(a.in[I_CMV], MVc, 2097152, gt, ngt);
        constexpr int I_IN = 32 * (NIN / 64), I_ME = 32 * 32;
        constexpr int NITEMS = I_IN + I_ME;
        for (int it = gw; it < NITEMS; it += NGW) {
            if (it < I_IN) transpose_item(a.in[I_WIN], NIN, Win_t, DM, 0, 0, scr, it, lane);
            else transpose_item(a.in[I_WMEM], DM, Wmem_t, DM, 0, 0, scr, it - I_IN, lane);
        }
        rms_rows_to_bf16(a.in[I_XP], a.in[I_NMIXPRE], XN, MP, gw, NGW, lane);
        rms_rows_to_bf16(a.in[I_MEM], a.in[I_NMEM], MEMN, NMEMROWS, gw, NGW, lane);
        rms_rows_to_bf16(a.in[I_XS], a.in[I_NMIXPRE], XN + (size_t)MP * DM, MS, gw, NGW, lane);
        for (int m = MP + MS + gw; m < MT; m += NGW) zero_row_bf16(XN + (size_t)m * DM, lane);
    }
    if (a.ws == nullptr) grid.sync();
    xcd_barrier(xbar);
    int vc = bx;
    {
      if (wave == 0) { const unsigned l = threadIdx.x & 63u; unsigned cnt = 0u; if (l < 16u) cnt = __hip_atomic_load(xrank + 16 * l, __ATOMIC_RELAXED, __HIP_MEMORY_SCOPE_AGENT);
          const bool good = l < 8u ? cnt == (unsigned)(G / 8) : (l < 16u ? cnt == 0u : true); const bool all_good = __all(good) && (G % 8 == 0);
          if (l == 0u) bst[3] = all_good ? 1u : 0u; }
      __syncthreads();
      if (bst[3] != 0u) vc = (int)bst[2] * 8 + (int)xbar.x; }
    vc = __builtin_amdgcn_readfirstlane(vc);
    const int vcu2 = (G % 8 == 0) ? (vc % 8) * (G / 8) + vc / 8 : vc;
#pragma unroll 1
    for (int rg = 0; rg < REP_G1; ++rg) {
        pg8::Gemm g{nullptr, nullptr, 0, 0, DM}; pg8::PhaseSched S; S.so.init(MP, NIN, G, vc); S.n0 = 128 * 52; S.n1 = 52 + 128; S.G = G; S.c = vc; S.mode = 1; S.nt0 = 32;
        S.A0 = (const char*)XN; S.B0 = (const char*)Win_t; S.A1 = (const char*)MEMN; S.B1 = (const char*)Wmem_t;
        pg8::EpiP1 E{pg8::EpiQKV{QKV, GT, a.in[I_BGATE], a.out}, pg8::EpiMem{MKp, MVp, a.out}};
        pg8::gemm_phase<pg8::EpiP1, pg8::PhaseSched, true, true>(lds, g, S, E);
        if (G == 256 ? vc >= 180 : true) {
            FRESH_TID(); LAS float* scr = (LAS float*)(lds + wave * 16640);
            constexpr int I_BR = 16 * 32, I_OU = 32 * 32, NIT = 3 * I_BR + I_OU;
            const int nwg = G == 256 ? 76 : G, w0 = G == 256 ? vc - 180 : vc;
            for (int it = w0 * NWAVES + wave; it < NIT; it += nwg * NWAVES) {
                int r = it;
                if (r < I_BR) { transpose_item(a.in[I_WBRA], DM, Wbr_t, 3072, 0, 0, scr, r, lane); continue; } r -= I_BR;
                if (r < I_BR) { transpose_item(a.in[I_WBRB], DM, Wbr_t, 3072, 1024, 0, scr, r, lane); continue; } r -= I_BR;
                if (r < I_BR) { transpose_item(a.in[I_WBRC], DM, Wbr_t, 3072, 2048, 0, scr, r, lane); continue; } r -= I_BR;
                transpose_item(a.in[I_WOUT], DM, Wout_t, DM, 0, 0, scr, r, lane);
            }
        }
    }
    xcd_barrier(xbar);
#pragma unroll 1
    for (int rep2 = 0; rep2 < REP_P2; ++rep2) {
        att::Ptrs P; P.QKV = QKV; P.OB = OB; P.MKp = MKp; P.MVp = MVp; P.KAc = KAc; P.VAc = VAc; P.KBc = KBc; P.VBc = VBc; P.MKc = MKc; P.MVc = MVc;
        P.relb = a.in[I_RELB]; P.subln = a.in[I_SUBLN];
        FRESH_TID();
        { const float s1 = wave_sum(a.in[I_LQ1][lane] * a.in[I_LK1][lane]), s2 = wave_sum(a.in[I_LQ2][lane] * a.in[I_LK2][lane]); P.lam = __expf(s1) - __expf(s2) + 0.2f; }
#pragma unroll 1
        for (int repa = 0; repa < REP_A; ++repa)
        for (int it = vcu2; it < 512; it += G) { const int bh = it >> 2, s = it & 3; att::unit_a<false>(lds, P, bh >> 3, bh & 7, s); att::unit_a<false>(lds, P, bh >> 3, bh & 7, 7 - s); }
        for (int it = vcu2; it < 256; it += G) { const int bh = it >> 1, half = it & 1;
#pragma unroll 1
            for (int i = 0; i < 4; ++i) att::unit_b<false>(lds, P, bh >> 3, bh & 7, 2 * i + half); }
        if (G == 256) {
            const int w = vcu2; int n = 0, u0 = 0, u1 = 0, u2 = 0, u3 = 0;
            if (w >= 64 && w < 160) { n = 2; u0 = 2 * (w - 64); u1 = u0 + 1; }
            else if (w >= 160) { const int j = w - 160; n = j < 32 ? 4 : 3; u0 = 192 + 2 * j; u1 = u0 + 1; u2 = 384 + j; u3 = 480 + j; }
#pragma unroll 1
            for (int i = 0; i < n; ++i) { const int it = i == 0 ? u0 : (i == 1 ? u1 : (i == 2 ? u2 : u3)); att::unit_c<false>(lds, P, it >> 5, (it >> 3) & 3, it & 7); }
        } else
        for (int it = vcu2; it < 512; it += G) att::unit_c<false>(lds, P, it >> 5, (it >> 3) & 3, it & 7);
        for (int it = vcu2; it < 160; it += G) {
            if (it < 64) att::unit_a<true>(lds, P, it >> 3, it & 7, 0);
            else if (it < 128) att::unit_b<true>(lds, P, (it - 64) >> 3, (it - 64) & 7, 0);
            else att::unit_c<true>(lds, P, (it - 128) >> 2, (it - 128) & 3, 0);
        }
    }
    xcd_barrier(xbar);
#pragma unroll 1
    for (int rg = 0; rg < REP_G3; ++rg) {
        pg8::Gemm g{nullptr, nullptr, 0, 0, 3072}; pg8::PhaseSched S; S.so.init(MP, DM, G, vc); S.n0 = 128 * 8; S.n1 = 24; S.G = G; S.c = vc; S.mode = 3; S.nt0 = 48;
        S.A0 = (const char*)OB; S.B0 = (const char*)Wbr_t; S.A1 = (const char*)(OB + (size_t)MP * 3072); S.B1 = S.B0;
        pg8::EpiMerge E{GT, MERGED, PSB};
        pg8::gemm_phase<pg8::EpiMerge, pg8::PhaseSched, true, true>(lds, g, S, E);
        if (G == 256 ? vc >= 24 : true) {
            FRESH_TID(); LAS float* scr = (LAS float*)(lds + wave * 16640);
            constexpr int I_FI = 32 * (2 * DFF / 64), I_FO = (DFF / 64) * 32, NIT = I_FI + I_FO;
            const int nwg = G == 256 ? 232 : G, w0 = G == 256 ? vc - 24 : vc;
            for (int it = w0 * NWAVES + wave; it < NIT; it += nwg * NWAVES) {
                if (it < I_FI) transpose_item(a.in[I_WFFI], 2 * DFF, Wffi_t, DM, 0, 1, scr, it, lane);
                else transpose_item(a.in[I_WFFO], DM, Wffo_t, DFF, 0, 0, scr, it - I_FI, lane);
            }
        }
    }
    xcd_barrier(xbar);
#pragma unroll 1
    for (int rg = 0; rg < REP_G4; ++rg) {
        pg8::Gemm g{nullptr, nullptr, 0, 0, DM}; pg8::PhaseSched S; S.so.init(MP, DM, G, vc); S.n0 = 128 * 8; S.n1 = 96; S.G = G; S.c = vc; S.mode = 4; S.nt0 = 32;
        S.A0 = (const char*)MERGED; S.B0 = (const char*)Wout_t; S.A1 = (const char*)PSB; S.B1 = S.B0;
        pg8::EpiF32 E{T, TS};
        pg8::gemm_phase<pg8::EpiF32, pg8::PhaseSched, true, true>(lds, g, S, E);
    }
    xcd_barrier(xbar);
#pragma unroll 1
    for (int rep5 = 0; rep5 < REP_P5; ++rep5) { FRESH_TID();
        const f32x4* g1 = (const f32x4*)a.in[I_NMIXPOST] + lane; const f32x4* g2 = (const f32x4*)a.in[I_NFFPRE] + lane;
        f32x4 xa[8], xb[8], ta[8], tb[8];
#define P5_LOAD(m_, X, Tv) do { const f32x4* xr_ = (const f32x4*)(a.in[I_XP] + (size_t)(m_) * DM) + lane; const v2u* tb_ = (const v2u*)(T + (size_t)(m_) * DM) + lane; \
        _Pragma("unroll") for (int j = 0; j < 8; ++j) { X[j] = __builtin_nontemporal_load(xr_ + 64 * j); Tv[j] = unpk4(tb_[64 * j]); } } while (0)
#define P5_PROC(m_, X, Tv) do { float s_ = 0.f; _Pragma("unroll") for (int j = 0; j < 8; ++j) s_ += (Tv[j].x * Tv[j].x + Tv[j].y * Tv[j].y) + (Tv[j].z * Tv[j].z + Tv[j].w * Tv[j].w); \
        const float rs_ = rsqrtf(wave_sum(s_) * (1.f / DM) + EPS); float s1_ = 0.f; v2u* x1r_ = (v2u*)(X1 + (size_t)(m_) * DM) + lane; \
        _Pragma("unroll") for (int j = 0; j < 8; ++j) { const f32x4 v_ = X[j] + Tv[j] * rs_ * g1[64 * j]; X[j] = v_; v2u w_; w_.x = pk2(v_.x, v_.y); w_.y = pk2(v_.z, v_.w); x1r_[64 * j] = w_; s1_ += (v_.x * v_.x + v_.y * v_.y) + (v_.z * v_.z + v_.w * v_.w); } \
        const float rs1_ = rsqrtf(wave_sum(s1_) * (1.f / DM) + EPS); v2u* o8_ = (v2u*)(H2 + (size_t)(m_) * DM) + lane; \
        _Pragma("unroll") for (int j = 0; j < 8; ++j) { v2u w_; const f32x4 gq_ = g2[64 * j]; w_.x = pk2(X[j].x * rs1_ * gq_.x, X[j].y * rs1_ * gq_.y); w_.y = pk2(X[j].z * rs1_ * gq_.z, X[j].w * rs1_ * gq_.w); o8_[64 * j] = w_; } } while (0)
        { int m = gw; if (m < MP) P5_LOAD(m, xa, ta);
          while (m < MP) {
            if (m + NGW < MP) P5_LOAD(m + NGW, xb, tb);
            __builtin_amdgcn_sched_barrier(0);
            P5_PROC(m, xa, ta); m += NGW; if (m >= MP) break;
            if (m + NGW < MP) P5_LOAD(m + NGW, xa, ta);
            __builtin_amdgcn_sched_barrier(0);
            P5_PROC(m, xb, tb); m += NGW;
          } }
        for (int m = MP + gw; m < MT; m += NGW) {
            if (m >= MP + MS) { zero_row_bf16(H2 + (size_t)m * DM, lane); continue; }
            const f32x4* tr = (const f32x4*)(TS + (size_t)(m - MP) * DM) + lane; const f32x4* xr_ = (const f32x4*)(a.in[I_XS] + (size_t)(m - MP) * DM) + lane;
#pragma unroll
            for (int j = 0; j < 8; ++j) { xa[j] = xr_[64 * j]; ta[j] = tr[64 * j]; }
#pragma unroll 1
            for (int ks = 1; ks < 12; ++ks) {
#pragma unroll
                for (int j = 0; j < 8; ++j) ta[j] += tr[64 * j + (size_t)ks * 256 * DM / 4]; }
            P5_PROC(m, xa, ta);
        }
#undef P5_LOAD
#undef P5_PROC
    }
    xcd_barrier(xbar);
#pragma unroll 1
    for (int rg = 0; rg < REP_G6; ++rg) {
        pg8::Gemm g{nullptr, nullptr, 0, 0, DM}; pg8::PhaseSched S; S.so.init(MT, 2 * DFF, G, vc); S.n0 = 129 * 44; S.n1 = 0; S.G = G; S.c = vc; S.mode = 0; S.nt0 = 32;
        S.A0 = (const char*)H2; S.B0 = (const char*)Wffi_t; S.A1 = S.A0; S.B1 = S.B0;
        pg8::EpiSwiGLU E{ACT};
        pg8::gemm_phase<pg8::EpiSwiGLU, pg8::PhaseSched, true, true>(lds, g, S, E);
    }
    xcd_barrier(xbar);
#pragma unroll 1
    for (int rg = 0; rg < REP_G7; ++rg) {
        pg8::Gemm g{nullptr, nullptr, 0, 0, DFF}; pg8::PhaseSched S; S.so.init(MP, DM, G, vc); S.n0 = 128 * 8; S.n1 = 88; S.G = G; S.c = vc; S.mode = 7; S.nt0 = 88;
        S.A0 = (const char*)ACT; S.B0 = (const char*)Wffo_t; S.A1 = (const char*)(ACT + (size_t)MP * DFF); S.B1 = S.B0;
        pg8::EpiF32 E{UB, US};
        pg8::gemm_phase<pg8::EpiF32, pg8::PhaseSched, true, true>(lds, g, S, E);
    }
    xcd_barrier(xbar);
#pragma unroll 1
    for (int rep8 = 0; rep8 < REP_P5; ++rep8) { FRESH_TID();
        f32x4 g1[8]; { const f32x4* p1 = (const f32x4*)a.in[I_NFFPOST] + lane;
#pragma unroll
            for (int j = 0; j < 8; ++j) g1[j] = p1[64 * j]; }
        f32x4 ua[8], ub[8]; v2u ca[8], cb[8];
#define P8_LOAD(m_, U, C) do { const v2u* ub_ = (const v2u*)(UB + (size_t)(m_) * DM) + lane; const v2u* x1_ = (const v2u*)(X1 + (size_t)(m_) * DM) + lane; \
        _Pragma("unroll") for (int j = 0; j < 8; ++j) { U[j] = unpk4(ub_[64 * j]); C[j] = x1_[64 * j]; } } while (0)
#define P8_PROC(yrow_, U, C) do { float s_ = 0.f; _Pragma("unroll") for (int j = 0; j < 8; ++j) s_ += (U[j].x * U[j].x + U[j].y * U[j].y) + (U[j].z * U[j].z + U[j].w * U[j].w); \
        const float rs_ = rsqrtf(wave_sum(s_) * (1.f / DM) + EPS); f32x4* yr_ = (f32x4*)(yrow_) + lane; \
        _Pragma("unroll") for (int j = 0; j < 8; ++j) yr_[64 * j] = unpk4(C[j]) + U[j] * rs_ * g1[j]; } while (0)
        { int m = gw; if (m < MP) P8_LOAD(m, ua, ca);
          while (m < MP) {
            if (m + NGW < MP) P8_LOAD(m + NGW, ub, cb);
            __builtin_amdgcn_sched_barrier(0);
            P8_PROC(a.out + OFF_Y + (size_t)m * DM, ua, ca); m += NGW; if (m >= MP) break;
            if (m + NGW < MP) P8_LOAD(m + NGW, ua, ca);
            __builtin_amdgcn_sched_barrier(0);
            P8_PROC(a.out + OFF_Y + (size_t)m * DM, ub, cb); m += NGW;
          } }
        for (int m = MP + gw; m < MP + MS; m += NGW) {
            const f32x4* us = (const f32x4*)(US + (size_t)(m - MP) * DM) + lane; const v2u* x1_ = (const v2u*)(X1 + (size_t)m * DM) + lane;
#pragma unroll
            for (int j = 0; j < 8; ++j) { ca[j] = x1_[64 * j]; ua[j] = us[64 * j]; }
#pragma unroll 1
            for (int ks = 1; ks < 11; ++ks) {
#pragma unroll
                for (int j = 0; j < 8; ++j) ua[j] += us[64 * j + (size_t)ks * 256 * DM / 4]; }
            P8_PROC(a.out + OFF_YS + (size_t)(m - MP) * DM, ua, ca);
        }
#undef P8_LOAD
#undef P8_PROC
    }
}

extern "C" void kernel_launch(void* const* d_in, const int* in_sizes, int n_in, void* d_out, int out_size, void* d_ws, size_t ws_size, hipStream_t stream) {
    static int grid = 0;
    if (grid == 0) {
        if (n_in != 29 || (long)out_size != OUT_TOTAL || ws_size < WS_CTL + 16384) { fprintf(stderr, "kernel_launch: unexpected shapes n_in %d out %d ws %zu\n", n_in, out_size, ws_size); grid = -1; return; }
        int dev = 0, cus = 0, per_cu = 0;
        hipGetDevice(&dev); hipDeviceGetAttribute(&cus, hipDeviceAttributeMultiprocessorCount, dev);
        if (hipFuncSetAttribute((const void*)fwd_megakernel, hipFuncAttributeMaxDynamicSharedMemorySize, LDS_BYTES) != hipSuccess) { fprintf(stderr, "kernel_launch: hipFuncSetAttribute failed\n"); grid = -1; return; }
        hipOccupancyMaxActiveBlocksPerMultiprocessor(&per_cu, (const void*)fwd_megakernel, NWAVES * 64, LDS_BYTES);
        if (per_cu < 1) { fprintf(stderr, "kernel_launch: occupancy query says %d blocks/CU\n", per_cu); per_cu = 1; }
        (void)hipGetLastError();
        grid = cus;
    }
    if (grid < 0) return;
    if (hipMemsetAsync((char*)d_ws + WS_CTL, 0, 16384, stream) != hipSuccess) { fprintf(stderr, "kernel_launch: hipMemsetAsync failed\n"); return; }
    Args a{};
    for (int i = 0; i < 29; ++i) a.in[i] = (const float*)d_in[i];
    a.out = (float*)d_out; a.ws = (unsigned char*)d_ws;
    void* args[] = {&a};
    hipError_t e = hipLaunchCooperativeKernel((const void*)fwd_megakernel, dim3(grid), dim3(NWAVES * 64), args, LDS_BYTES, stream);
    if (e != hipSuccess) fprintf(stderr, "cooperative launch failed: %s (grid %d)\n", hipGetErrorString(e), grid);
}
```

```cpp
#include <hip/hip_runtime.h>
#include <hip/hip_cooperative_groups.h>
#include <cstdio>
#include <cstdint>
namespace cg = cooperative_groups;

constexpr int DM = 2048, MP = 32768, MS = 128, MT = 33024;
constexpr int NIN = 13312, NQKV = 7168, NG = 6144, DFF = 5632, NMEMROWS = 4096;
constexpr float EPS = 1e-6f, LOG2E = 1.4426950408889634f;
constexpr float SC_A = 0.125f * LOG2E, SC_B = 0.08838834764831845f * LOG2E, SC_C = 0.0625f * LOG2E;
constexpr long OFF_Y = 0, OFF_YS = 67108864L, OFF_AKP = OFF_YS + 262144L, OFF_AVP = OFF_AKP + 33554432L, OFF_BKP = OFF_AVP + 33554432L,
               OFF_BVP = OFF_BKP + 8388608L, OFF_MKP = OFF_BVP + 8388608L, OFF_MVP = OFF_MKP + 4194304L, OFF_AKS = OFF_MVP + 4194304L,
               OFF_AVS = OFF_AKS + 131072L, OFF_BKS = OFF_AVS + 131072L, OFF_BVS = OFF_BKS + 131072L, OUT_TOTAL = OFF_BVS + 131072L;
constexpr size_t WS_WIN = 0, WS_WMEM = WS_WIN + (size_t)NIN * DM * 2, WS_WBR = WS_WMEM + (size_t)DM * DM * 2, WS_WOUT = WS_WBR + (size_t)DM * 3072 * 2,
                 WS_WFFI = WS_WOUT + (size_t)DM * DM * 2, WS_WFFO = WS_WFFI + (size_t)2 * DFF * DM * 2, WS_QKV = WS_WFFO + (size_t)DM * DFF * 2,
                 WS_G = WS_QKV + (size_t)MT * NQKV * 2, WS_MEMN = WS_G + (size_t)MT * NG * 2, WS_MKP = WS_MEMN + (size_t)NMEMROWS * DM * 2,
                 WS_MVP = WS_MKP + (size_t)NMEMROWS * 1024 * 2, WS_END = WS_MVP + (size_t)NMEMROWS * 1024 * 2;
constexpr size_t WS_CTL = WS_END;
static_assert(WS_CTL % 256 == 0 && WS_CTL + 16384 <= 1073741824ull, "d_ws map");
constexpr size_t WS_MERGED = WS_QKV, WS_T = WS_QKV + (size_t)MT * DM * 2, WS_ACT = WS_QKV;
constexpr size_t WS_TS = WS_QKV + (size_t)MT * DM * 4, WS_US = WS_QKV + (size_t)MT * DFF * 2;
constexpr size_t WS_PS = WS_TS + (size_t)12 * 256 * DM * 4;
static_assert(WS_PS + (size_t)3 * 256 * DM * 2 <= WS_G && WS_US + (size_t)11 * 256 * DM * 4 <= WS_G, "partials");
constexpr size_t WS_X1 = WS_G, WS_H2 = WS_G + (size_t)MT * DM * 2;
static_assert(WS_T + (size_t)MT * DM * 4 <= WS_G && WS_H2 + (size_t)MT * DM * 2 <= WS_MEMN && WS_ACT + (size_t)MT * DFF * 2 <= WS_G, "overlays");
constexpr size_t YS_XN = 0, YS_OB = 0, YS_KAC = 203423744ull, YS_VAC = YS_KAC + 16777216ull, YS_KBC = YS_VAC + 16777216ull, YS_VBC = YS_KBC + 8388608ull,
                 YS_MKC = YS_VBC + 8388608ull, YS_MVC = YS_MKC + 4194304ull, YS_END = YS_MVC + 4194304ull;
static_assert((size_t)MT * 3072 * 2 <= YS_KAC && YS_END <= 268435456ull, "y scratch map");

#define LAS __attribute__((address_space(3)))
namespace pg8 {
#define PG8_LAS __attribute__((address_space(3)))
typedef unsigned short bf16_t;
typedef short bf16x8 __attribute__((ext_vector_type(8)));
typedef float f32x4 __attribute__((ext_vector_type(4)));
typedef unsigned u32x4 __attribute__((ext_vector_type(4)));
constexpr int BM = 256, BK = 64, HALF = 128, HTB = HALF * BK * 2  , STAGE_BYTES = 8 * HTB, NXCD = 8, WGM = 4;

__host__ __device__ __forceinline__ int lds_byte(int r, int c) { const int st = (r >> 4) * 2 + (c >> 5), rr = r & 15, cc = c & 31, ob = rr * 64 + cc * 2; return st * 1024 + (ob ^ (((ob >> 9) & 1) << 5)); }
__host__ __device__ __forceinline__ void stage_rc(int b, int& R, int& C) { const int st = b / 1024, sb = b % 1024, swz = sb ^ (((sb >> 9) & 1) << 5); R = (st >> 1) * 16 + swz / 64; C = (st & 1) * 32 + (swz % 64) / 2; }
__host__ __device__ __forceinline__ int perm32(int rho) { const int n = rho >> 4, i = rho & 15; return 8 * (i >> 2) + 4 * n + (i & 3); }

struct Unit { int pm, pn, kind, aux; };
struct Gemm { const bf16_t* A; const bf16_t* Bt; int M, N, K; };

struct StaticOrder {
    int nM, nN, nwg, G, c;
    __host__ __device__ void init(int M, int N, int G_, int c_) { nM = M / BM; nN = N / BM; nwg = nM * nN; G = G_; c = c_; }
    __host__ __device__ bool next(int i, Unit& u) const {
        const long L = (long)i * G + c; if (L >= nwg) return false;
        int wgid = (int)L; { const int q = nwg / NXCD, r = nwg % NXCD, xcd = wgid % NXCD, off = wgid / NXCD; wgid = (xcd < r ? xcd * (q + 1) : r * (q + 1) + (xcd - r) * q) + off; }
        const int nig = WGM * nN, gid = wgid / nig, fm = gid * WGM, gsz = (nM - fm) < WGM ? (nM - fm) : WGM;
        u.pm = fm + ((wgid % nig) % gsz); u.pn = (wgid % nig) / gsz; return true;
    }
    __device__ __forceinline__ void a_ready(const Unit&) const {}
    __device__ __forceinline__ void done(const Unit&) const {}
};


struct PhaseSched {
    StaticOrder so; int n0, n1, G, c, mode, nt0;
    const char *A0, *B0, *A1, *B1;
    __device__ __forceinline__ bool next(int i, Unit& u) const {
        const long L = (long)i * G + c;
        if (L < n0) { so.next(i, u); u.kind = 0; u.aux = 0; return true; }
        if (L >= n0 + n1) return false;
        const int j = (int)L - n0; u.aux = 0;
        if (mode == 1) { if (j < 52) { u.kind = 0; u.pm = 128; u.pn = j; } else { u.kind = 1; u.pm = (j - 52) >> 3; u.pn = (j - 52) & 7; } }
        else { u.kind = 1; u.pm = 0; u.pn = j & 7; u.aux = j >> 3; }
        return true;
    }
    __device__ __forceinline__ size_t aoff(int aux) const { return mode == 3 ? (size_t)aux * 2048 : (mode == 4 ? (size_t)(aux >> 2) * 1048576 + (size_t)(aux & 3) * 1024 : (size_t)aux * 1024); }
    __device__ __forceinline__ size_t boff(int aux) const { return mode == 3 ? (size_t)aux * 2048 : (mode == 4 ? (size_t)(aux & 3) * 1024 : (size_t)aux * 1024); }
    __device__ __forceinline__ const char* abase(const Unit& u, size_t tstep) const { return u.kind == 0 ? A0 + (size_t)u.pm * tstep : A1 + (size_t)u.pm * tstep + aoff(u.aux); }
    __device__ __forceinline__ const char* bbase(const Unit& u, size_t tstep) const { return u.kind == 0 ? B0 + (size_t)u.pn * tstep : B1 + (size_t)u.pn * tstep + boff(u.aux); }
    __device__ __forceinline__ int nt(const Unit& u) const { return (u.kind == 0 || mode == 1) ? nt0 : (mode == 3 ? 16 : 8); }
    __device__ __forceinline__ void a_ready(const Unit&) const {}
    __device__ __forceinline__ void done(const Unit&) const {}
};
typedef float f32x2 __attribute__((ext_vector_type(2)));
typedef __bf16 bf16x2v __attribute__((ext_vector_type(2)));
__device__ __forceinline__ unsigned cvt_pk_bf16(float lo, float hi) { f32x2 v = {lo, hi}; bf16x2v b = __builtin_convertvector(v, bf16x2v); return __builtin_bit_cast(unsigned, b); }
__device__ __forceinline__ u32x4 pack8(f32x4 v0, f32x4 v1) { u32x4 w; w.x = cvt_pk_bf16(v0[0], v0[1]); w.y = cvt_pk_bf16(v0[2], v0[3]); w.z = cvt_pk_bf16(v1[0], v1[1]); w.w = cvt_pk_bf16(v1[2], v1[3]); return w; }
__device__ __forceinline__ float bflo(unsigned w) { return __uint_as_float(w << 16); }
__device__ __forceinline__ float bfhi(unsigned w) { return __uint_as_float(w & 0xffff0000u); }
__device__ __forceinline__ float sigmoidf_(float x) { return __builtin_amdgcn_rcpf(1.0f + __builtin_amdgcn_exp2f(-x * LOG2E)); }

struct EpiQKV {
    static constexpr bool PERM = true, HOOK = false;
    bf16_t* QKV; bf16_t* G; const float* bgate; float* out;
    __device__ __forceinline__ void operator()(const f32x4 (&acc)[2][2][4][2], const Unit& u, int wr, int wc, int fr, int fq) const {
        const int colt = u.pn * BM, seg = colt >> 10, row0 = u.pm * BM + wr * 64 + fr, cl = wc * 32 + fq * 8;
        if (seg < 7) {
            const float sc = seg == 0 ? SC_A : (seg == 3 ? SC_B : (seg == 6 ? SC_C : 1.f));
            const bool f32o = (seg == 1 || seg == 2 || seg == 4 || seg == 5), isb = seg >= 4;
            const long ob_p = seg == 1 ? OFF_AKP : (seg == 2 ? OFF_AVP : (seg == 4 ? OFF_BKP : OFF_BVP));
            const long ob_s = seg == 1 ? OFF_AKS : (seg == 2 ? OFF_AVS : (seg == 4 ? OFF_BKS : OFF_BVS));
#pragma unroll
            for (int ai = 0; ai < 2; ++ai)
#pragma unroll
                for (int m = 0; m < 4; ++m) {
                    const int row = row0 + ai * HALF + m * 16;
                    float* fo = nullptr;
                    if (f32o) {
                        if (row < MP) { if (!isb) fo = out + ob_p + (long)row * 1024; else { const int s = row & 2047; if (s >= 1536) fo = out + ob_p + ((long)(row >> 11) * 512 + (s - 1536)) * 1024; } }
                        else if (row < MP + MS) fo = out + ob_s + (long)(row - MP) * 1024;
                    }
#pragma unroll
                    for (int bj = 0; bj < 2; ++bj) {
                        const int col = colt + bj * HALF + cl; const f32x4 v0 = acc[ai][bj][m][0], v1 = acc[ai][bj][m][1];
                        *(u32x4*)(QKV + (size_t)row * NQKV + col) = (seg == 0 || seg == 3 || seg == 6) ? pack8(v0 * sc, v1 * sc) : pack8(v0, v1);
                        if (fo) { const int c1 = col & 1023; *(f32x4*)(fo + c1) = v0; *(f32x4*)(fo + c1 + 4) = v1; }
                    }
                }
        } else {
#pragma unroll
            for (int bj = 0; bj < 2; ++bj) {
                const int gc = colt - NQKV + bj * HALF + cl; const f32x4 b0 = *(const f32x4*)(bgate + gc), b1 = *(const f32x4*)(bgate + gc + 4);
#pragma unroll
                for (int ai = 0; ai < 2; ++ai)
#pragma unroll
                    for (int m = 0; m < 4; ++m) {
                        const int row = row0 + ai * HALF + m * 16; f32x4 v0 = acc[ai][bj][m][0] + b0, v1 = acc[ai][bj][m][1] + b1;
#pragma unroll
                        for (int e = 0; e < 4; ++e) { v0[e] = fmaxf(sigmoidf_(v0[e]), 1e-6f); v1[e] = fmaxf(sigmoidf_(v1[e]), 1e-6f); }
                        *(u32x4*)(G + (size_t)row * NG + gc) = pack8(v0, v1);
                    }
            }
        }
    }
};
struct EpiMem {
    static constexpr bool PERM = true, HOOK = false;
    bf16_t* MK; bf16_t* MV; float* out;
    __device__ __forceinline__ void operator()(const f32x4 (&acc)[2][2][4][2], const Unit& u, int wr, int wc, int fr, int fq) const {
        const int colt = u.pn * BM, isv = colt >> 10, row0 = u.pm * BM + wr * 64 + fr, cl = (colt & 1023) + wc * 32 + fq * 8;
        bf16_t* B = isv ? MV : MK; float* F = out + (isv ? OFF_MVP : OFF_MKP);
#pragma unroll
        for (int ai = 0; ai < 2; ++ai)
#pragma unroll
            for (int m = 0; m < 4; ++m) {
                const int row = row0 + ai * HALF + m * 16;
#pragma unroll
                for (int bj = 0; bj < 2; ++bj) {
                    const int col = bj * HALF + cl; const f32x4 v0 = acc[ai][bj][m][0], v1 = acc[ai][bj][m][1];
                    *(u32x4*)(B + (size_t)row * 1024 + col) = pack8(v0, v1);
                    *(f32x4*)(F + (size_t)row * 1024 + col) = v0; *(f32x4*)(F + (size_t)row * 1024 + col + 4) = v1;
                }
            }
    }
};
struct EpiP1 {
    static constexpr bool PERM = true, HOOK = false;
    EpiQKV q; EpiMem m;
    __device__ __forceinline__ void operator()(const f32x4 (&acc)[2][2][4][2], const Unit& u, int wr, int wc, int fr, int fq) const { if (u.kind == 0) q(acc, u, wr, wc, fr, fq); else m(acc, u, wr, wc, fr, fq); }
};
struct EpiMerge {
    static constexpr bool PERM = true, HOOK = true;
    const bf16_t* G; bf16_t* O; bf16_t* PS;
    __device__ __forceinline__ void hook(f32x4 (&acc)[2][2][4][2], const Unit& u, int seg, int wr, int wc, int fr, int fq) const {
        const int row0 = u.pm * BM + wr * 64 + fr, col0 = u.pn * BM + wc * 32 + fq * 8;
        const bf16_t* gp0 = G + (size_t)row0 * NG + (size_t)(seg - 1) * DM + col0;
#pragma unroll
        for (int ai = 0; ai < 2; ++ai) {
            u32x4 ga[4][2], gb[4][2];
#pragma unroll
            for (int m = 0; m < 4; ++m)
#pragma unroll
                for (int bj = 0; bj < 2; ++bj) { const bf16_t* gp = gp0 + (size_t)(ai * HALF + m * 16) * NG + bj * HALF; ga[m][bj] = *(const u32x4*)(gp); gb[m][bj] = *(const u32x4*)(gp + DM); }
#pragma unroll
            for (int m = 0; m < 4; ++m)
#pragma unroll
                for (int bj = 0; bj < 2; ++bj) {
                    const u32x4 a = ga[m][bj], b = gb[m][bj];
                    f32x4 r0, r1;
                    r0[0] = bflo(a.x) * __builtin_amdgcn_rcpf(bflo(b.x)); r0[1] = bfhi(a.x) * __builtin_amdgcn_rcpf(bfhi(b.x));
                    r0[2] = bflo(a.y) * __builtin_amdgcn_rcpf(bflo(b.y)); r0[3] = bfhi(a.y) * __builtin_amdgcn_rcpf(bfhi(b.y));
                    r1[0] = bflo(a.z) * __builtin_amdgcn_rcpf(bflo(b.z)); r1[1] = bfhi(a.z) * __builtin_amdgcn_rcpf(bfhi(b.z));
                    r1[2] = bflo(a.w) * __builtin_amdgcn_rcpf(bflo(b.w)); r1[3] = bfhi(a.w) * __builtin_amdgcn_rcpf(bfhi(b.w));
                    acc[ai][bj][m][0] *= r0; acc[ai][bj][m][1] *= r1;
                }
            asm volatile("" ::: "memory");
        }
    }
    __device__ __forceinline__ void operator()(const f32x4 (&acc)[2][2][4][2], const Unit& u, int wr, int wc, int fr, int fq) const {
        const int row0 = u.pm * BM + wr * 64 + fr, col0 = u.pn * BM + wc * 32 + fq * 8;
        const bf16_t* Gb = u.kind == 0 ? G + (size_t)row0 * NG + 2 * DM + col0 : G + (size_t)(MP + row0) * NG + (size_t)u.aux * DM + col0;
        bf16_t* Ob = u.kind == 0 ? O + (size_t)row0 * DM + col0 : PS + ((size_t)u.aux * 256 + row0) * DM + col0;
#pragma unroll
        for (int ai = 0; ai < 2; ++ai) {
            u32x4 gg[4][2];
#pragma unroll
            for (int m = 0; m < 4; ++m)
#pragma unroll
                for (int bj = 0; bj < 2; ++bj) gg[m][bj] = *(const u32x4*)(Gb + (size_t)(ai * HALF + m * 16) * NG + bj * HALF);
#pragma unroll
            for (int m = 0; m < 4; ++m) {
#pragma unroll
                for (int bj = 0; bj < 2; ++bj) {
                    const u32x4 g = gg[m][bj];
                    f32x4 v0 = acc[ai][bj][m][0], v1 = acc[ai][bj][m][1];
                    v0[0] *= bflo(g.x); v0[1] *= bfhi(g.x); v0[2] *= bflo(g.y); v0[3] *= bfhi(g.y); v1[0] *= bflo(g.z); v1[1] *= bfhi(g.z); v1[2] *= bflo(g.w); v1[3] *= bfhi(g.w);
                    *(u32x4*)(Ob + (size_t)(ai * HALF + m * 16) * DM + bj * HALF) = pack8(v0, v1);
                }
            }
            asm volatile("" ::: "memory");
        }
    }
};
struct EpiF32 {
    static constexpr bool PERM = true, HOOK = false;
    bf16_t* basep; float* part;
    __device__ __forceinline__ void operator()(const f32x4 (&acc)[2][2][4][2], const Unit& u, int wr, int wc, int fr, int fq) const {
        const int row0 = u.pm * BM + wr * 64 + fr, col0 = u.pn * BM + wc * 32 + fq * 8;
        if (u.kind == 0) {
#pragma unroll
            for (int ai = 0; ai < 2; ++ai)
#pragma unroll
                for (int m = 0; m < 4; ++m) {
                    bf16_t* p = basep + (size_t)(row0 + ai * HALF + m * 16) * DM;
#pragma unroll
                    for (int bj = 0; bj < 2; ++bj) *(u32x4*)(p + col0 + bj * HALF) = pack8(acc[ai][bj][m][0], acc[ai][bj][m][1]);
                }
        } else {
            float* base = part + (size_t)u.aux * 256 * DM;
#pragma unroll
            for (int ai = 0; ai < 2; ++ai)
#pragma unroll
                for (int m = 0; m < 4; ++m) {
                    float* p = base + (size_t)(row0 + ai * HALF + m * 16) * DM;
#pragma unroll
                    for (int bj = 0; bj < 2; ++bj) { const int col = col0 + bj * HALF; *(f32x4*)(p + col) = acc[ai][bj][m][0]; *(f32x4*)(p + col + 4) = acc[ai][bj][m][1]; }
                }
        }
    }
};
struct EpiSwiGLU {
    static constexpr bool PERM = true, HOOK = false;
    bf16_t* O;
    __device__ __forceinline__ void operator()(const f32x4 (&acc)[2][2][4][2], const Unit& u, int wr, int wc, int fr, int fq) const {
        const int row0 = u.pm * BM + wr * 64 + fr, col = u.pn * HALF + wc * 32 + fq * 8;
#pragma unroll
        for (int ai = 0; ai < 2; ++ai)
#pragma unroll
            for (int m = 0; m < 4; ++m) {
                const int row = row0 + ai * HALF + m * 16; f32x4 v0, v1;
#pragma unroll
                for (int e = 0; e < 4; ++e) { const float a0 = acc[ai][0][m][0][e], a1 = acc[ai][0][m][1][e]; v0[e] = a0 * sigmoidf_(a0) * acc[ai][1][m][0][e]; v1[e] = a1 * sigmoidf_(a1) * acc[ai][1][m][1][e]; }
                *(u32x4*)(O + (size_t)row * DFF + col) = pack8(v0, v1);
            }
    }
};
template <class Epi, class Sched, bool ALIGN_EPI = false, bool SP2 = false>
__device__ __forceinline__ void gemm_phase(PG8_LAS unsigned char* lds, const Gemm g, const Sched& S, const Epi& E) {
    int tid_l = threadIdx.x; asm volatile("" : "+v"(tid_l));
    const int tid = tid_l, wid = __builtin_amdgcn_readfirstlane(tid >> 6), lane = tid & 63, wr = wid >> 2, wc = wid & 3, fr = lane & 15, fq = lane >> 4;
    const int K = g.K;
    unsigned voffA[2], voffB[2];
#pragma unroll
    for (int i = 0; i < 2; ++i) { int R, C; stage_rc(tid * 16 + i * 8192, R, C); const int Rb = Epi::PERM ? ((R & ~31) + perm32(R & 31)) : R;
        voffA[i] = (unsigned)(R * K + C) * 2u; voffB[i] = (unsigned)(Rb * K + C) * 2u; }
    const size_t kstep = (size_t)(BK * 2);
    const size_t hstep = (size_t)HALF * K * 2;
    const size_t tstep = 2 * hstep;
    const unsigned ldsw = (unsigned)wid * 1024u;
    const int aoff = lds_byte(wr * 64 + fr, fq * 8), boff = lds_byte(wc * 32 + fr, fq * 8);
#define PG8_SA(b, h) (((b) * 2 + (h)) * HTB)
#define PG8_SB(b, h) ((4 + (b) * 2 + (h)) * HTB)
#define PG8_STAGE(bufoff, gbase, voff) do { _Pragma("unroll") for (int _i = 0; _i < 2; ++_i) \
        __builtin_amdgcn_global_load_lds((const unsigned*)((const char*)(gbase) + (voff)[_i]), (PG8_LAS unsigned*)(lds + (bufoff) + ldsw + _i * 8192), 16, 0, 0); } while (0)
#define PG8_LDA(dst, b, h) do { _Pragma("unroll") for (int m = 0; m < 4; ++m) _Pragma("unroll") for (int k = 0; k < 2; ++k) dst[m][k] = *(const PG8_LAS bf16x8*)(lds + PG8_SA(b, h) + aoff + m * 2048 + k * 1024); } while (0)
#define PG8_LDB(dst, b, h) do { _Pragma("unroll") for (int n = 0; n < 2; ++n) _Pragma("unroll") for (int k = 0; k < 2; ++k) dst[n][k] = *(const PG8_LAS bf16x8*)(lds + PG8_SB(b, h) + boff + n * 2048 + k * 1024); } while (0)
#define PG8_MMA(ai, bj, At, Bt) do { __builtin_amdgcn_s_setprio(1); _Pragma("unroll") for (int m = 0; m < 4; ++m) _Pragma("unroll") for (int n = 0; n < 2; ++n) _Pragma("unroll") for (int k = 0; k < 2; ++k) \
        acc[ai][bj][m][n] = __builtin_amdgcn_mfma_f32_16x16x32_bf16(Bt[n][k], At[m][k], acc[ai][bj][m][n], 0, 0, 0); __builtin_amdgcn_s_setprio(0); } while (0)
#define PG8_WAIT_V(n) asm volatile("s_waitcnt vmcnt(" #n ")" ::: "memory")
#define PG8_WAIT_L(n) asm volatile("s_waitcnt lgkmcnt(" #n ")" ::: "memory")
#define PG8_BAR __builtin_amdgcn_s_barrier()
#define PG8_SCHED __builtin_amdgcn_sched_barrier(0)
    Unit cur, nxt; int ui = 0;
    if (!S.next(0, cur)) return;
    f32x4 acc[2][2][4][2];
#pragma unroll
    for (int a = 0; a < 2; ++a)
#pragma unroll
        for (int b = 0; b < 2; ++b)
#pragma unroll
            for (int m = 0; m < 4; ++m)
#pragma unroll
                for (int n = 0; n < 2; ++n) acc[a][b][m][n] = (f32x4){0.f, 0.f, 0.f, 0.f};
    bf16x8 At[4][2], B0[2][2], B1[2][2];
    const char* cA = S.abase(cur, tstep); const char* cB = S.bbase(cur, tstep);
    S.a_ready(cur);
    if constexpr (SP2) {
        PG8_STAGE(PG8_SB(0, 0), cB, voffB); PG8_STAGE(PG8_SB(0, 1), cB + hstep, voffB); PG8_STAGE(PG8_SA(0, 0), cA, voffA); PG8_STAGE(PG8_SA(0, 1), cA + hstep, voffA);
        if (wr == 1) PG8_BAR;
        PG8_WAIT_V(2); PG8_BAR;
        PG8_STAGE(PG8_SB(1, 0), cB + kstep, voffB); PG8_STAGE(PG8_SA(1, 0), cA + kstep, voffA); PG8_STAGE(PG8_SB(1, 1), cB + hstep + kstep, voffB);
        PG8_WAIT_V(6); PG8_BAR;
    } else {
        PG8_STAGE(PG8_SB(0, 0), cB, voffB); PG8_STAGE(PG8_SA(0, 0), cA, voffA); PG8_STAGE(PG8_SB(0, 1), cB + hstep, voffB); PG8_STAGE(PG8_SA(0, 1), cA + hstep, voffA);
        if (wr == 1) PG8_BAR;
        PG8_WAIT_V(4); PG8_BAR;
        PG8_STAGE(PG8_SB(1, 0), cB + kstep, voffB); PG8_STAGE(PG8_SA(1, 0), cA + kstep, voffA); PG8_STAGE(PG8_SB(1, 1), cB + hstep + kstep, voffB);
        PG8_WAIT_V(6); PG8_BAR;
    }
    for (;;) {
        const bool has_next = S.next(ui + 1, nxt);
        const char* nA = has_next ? S.abase(nxt, tstep) : cA; const char* nB = has_next ? S.bbase(nxt, tstep) : cB;
        const int nt = S.nt(cur);
        for (int t = 0; t < nt; t += 2) {
            const bool last = (t == nt - 2);
            if constexpr (Epi::HOOK) { if (t == 16 || t == 32) E.hook(acc, cur, t >> 4, wr, wc, fr, fq); }
            const char* a1 = cA + (size_t)(t + 1) * kstep;
            const char* a2 = last ? nA : cA + (size_t)(t + 2) * kstep; const char* b2 = last ? nB : cB + (size_t)(t + 2) * kstep;
            const char* a3 = a2 + kstep; const char* b3 = b2 + kstep;
            if (last && has_next) S.a_ready(nxt);
            if constexpr (SP2) {
            PG8_LDB(B0, 0, 0); PG8_LDB(B1, 0, 1); PG8_SCHED; PG8_LDA(At, 0, 0); PG8_STAGE(PG8_SA(1, 1), a1 + hstep, voffA);
            PG8_WAIT_V(8); PG8_WAIT_L(0); PG8_BAR; PG8_MMA(0, 0, At, B0); PG8_MMA(0, 1, At, B1); PG8_BAR; PG8_SCHED;
            PG8_LDA(At, 0, 1); PG8_STAGE(PG8_SB(0, 0), b2, voffB); PG8_STAGE(PG8_SB(0, 1), b2 + hstep, voffB); PG8_STAGE(PG8_SA(0, 0), a2, voffA);
            PG8_WAIT_V(8); PG8_WAIT_L(0); PG8_BAR; PG8_MMA(1, 0, At, B0); PG8_MMA(1, 1, At, B1); PG8_BAR; PG8_SCHED;
            PG8_LDB(B0, 1, 0); PG8_LDB(B1, 1, 1); PG8_SCHED; PG8_LDA(At, 1, 0); PG8_STAGE(PG8_SA(0, 1), a2 + hstep, voffA);
            PG8_WAIT_V(8); PG8_WAIT_L(0); PG8_BAR; PG8_MMA(0, 0, At, B0); PG8_MMA(0, 1, At, B1); PG8_BAR; PG8_SCHED;
            PG8_LDA(At, 1, 1); PG8_STAGE(PG8_SB(1, 0), b3, voffB); PG8_STAGE(PG8_SB(1, 1), b3 + hstep, voffB); PG8_STAGE(PG8_SA(1, 0), a3, voffA);
            PG8_WAIT_V(8); PG8_WAIT_L(0); PG8_BAR; PG8_MMA(1, 0, At, B0); PG8_MMA(1, 1, At, B1); PG8_BAR; PG8_SCHED;
            } else {
            PG8_LDB(B0, 0, 0); PG8_SCHED; PG8_LDA(At, 0, 0); PG8_STAGE(PG8_SA(1, 1), a1 + hstep, voffA);
            PG8_WAIT_L(8); PG8_BAR; PG8_WAIT_L(0); PG8_MMA(0, 0, At, B0); PG8_BAR; PG8_SCHED;
            PG8_LDB(B1, 0, 1); PG8_STAGE(PG8_SB(0, 0), b2, voffB);
            PG8_BAR; PG8_WAIT_L(0); PG8_MMA(0, 1, At, B1); PG8_BAR;
            PG8_LDA(At, 0, 1); PG8_STAGE(PG8_SA(0, 0), a2, voffA);
            PG8_BAR; PG8_WAIT_L(0); PG8_MMA(1, 0, At, B0); PG8_BAR; PG8_SCHED;
            PG8_STAGE(PG8_SB(0, 1), b2 + hstep, voffB);
            PG8_WAIT_V(6); PG8_BAR; PG8_MMA(1, 1, At, B1); PG8_BAR;
            PG8_LDB(B0, 1, 0); PG8_SCHED; PG8_LDA(At, 1, 0); PG8_STAGE(PG8_SA(0, 1), a2 + hstep, voffA);
            PG8_WAIT_L(8); PG8_BAR; PG8_WAIT_L(0); PG8_MMA(0, 0, At, B0); PG8_BAR; PG8_SCHED;
            PG8_LDB(B1, 1, 1); PG8_STAGE(PG8_SB(1, 0), b3, voffB);
            PG8_BAR; PG8_WAIT_L(0); PG8_MMA(0, 1, At, B1); PG8_BAR;
            PG8_LDA(At, 1, 1); PG8_STAGE(PG8_SA(1, 0), a3, voffA);
            PG8_BAR; PG8_WAIT_L(0); PG8_MMA(1, 0, At, B0); PG8_BAR; PG8_SCHED;
            PG8_STAGE(PG8_SB(1, 1), b3 + hstep, voffB);
            PG8_WAIT_V(6); PG8_BAR; PG8_MMA(1, 1, At, B1); PG8_BAR;
            }
        }
        if constexpr (ALIGN_EPI) { if (wr == 0) PG8_BAR; }
        E(acc, cur, wr, wc, fr, fq);
        if (!has_next) break;
#pragma unroll
        for (int a = 0; a < 2; ++a)
#pragma unroll
            for (int b = 0; b < 2; ++b)
#pragma unroll
                for (int m = 0; m < 4; ++m)
#pragma unroll
                    for (int n = 0; n < 2; ++n) acc[a][b][m][n] = (f32x4){0.f, 0.f, 0.f, 0.f};
        cur = nxt; cA = nA; cB = nB; ++ui;
        if constexpr (ALIGN_EPI) { if (wr == 1) PG8_BAR; }
    }
    PG8_WAIT_V(0);
    if constexpr (!ALIGN_EPI) { if (wr == 0) PG8_BAR; }
    PG8_BAR;
#undef PG8_SA
#undef PG8_SB
#undef PG8_STAGE
#undef PG8_LDA
#undef PG8_LDB
#undef PG8_MMA
#undef PG8_WAIT_V
#undef PG8_WAIT_L
#undef PG8_BAR
#undef PG8_SCHED
}
}
namespace att {
typedef unsigned short bf16_t;
typedef short bf16x8 __attribute__((ext_vector_type(8)));
typedef short s16x4 __attribute__((ext_vector_type(4)));
typedef float f32x16 __attribute__((ext_vector_type(16)));
typedef unsigned u32x4 __attribute__((ext_vector_type(4)));
constexpr float NEG = -1e30f;
constexpr int WSF_OFF = 98304, TAB_OFF = WSF_OFF + 1024;
__device__ __forceinline__ int crow(int r, int h) { return (r & 3) + 8 * (r >> 2) + 4 * h; }
__device__ __forceinline__ s16x4 vtr(const LAS unsigned char* p) { return __builtin_bit_cast(s16x4, __builtin_amdgcn_ds_read_tr16_b64_v4i16((LAS s16x4*)p)); }
__device__ __forceinline__ unsigned short f2bf(float f) { unsigned u = __float_as_uint(f); return (unsigned short)((u + 0x7fffu + ((u >> 16) & 1u)) >> 16); }
__device__ __forceinline__ float bf2f(unsigned short b) { return __uint_as_float((unsigned)b << 16); }

__device__ __forceinline__ float xmax32(float m) {
    const auto rr = __builtin_amdgcn_permlane32_swap(__float_as_uint(m), __float_as_uint(m), false, false);
    return fmaxf(__uint_as_float(rr[0]), __uint_as_float(rr[1]));
}
__device__ __forceinline__ float xadd32(float v) {
    const auto rr = __builtin_amdgcn_permlane32_swap(__float_as_uint(v), __float_as_uint(v), false, false);
    return __uint_as_float(rr[0]) + __uint_as_float(rr[1]);
}
template <int NKS, int NB, int MODE, bool MASKK>
__device__ __forceinline__ void attn_pass(LAS unsigned char* lds, const bf16_t* qptr, int qpitch,
        const bf16_t* kb0, const bf16_t* vb0, int pitch0, const bf16_t* kb1, const bf16_t* vb1, int pitch1, int split,
        int t0, int t1, int wt0, int wt1, int qpos, int kpos0, float modc, int cwrel, int nkeys, f32x16 (&O)[4]) {
    constexpr int TK = 32 * NB, KP = NKS * 16 + 8, VP = 160;
    constexpr int KBYTES = TK * KP * 2, VBYTES = TK * VP * 2, STAGE = KBYTES + VBYTES;
    constexpr int KCPR = NKS * 2, KCH = TK * KCPR / 512, VCH = TK * 16 / 512;
    static_assert(KCH >= 1 && VCH >= 1 && 2 * STAGE <= WSF_OFF, "attention tile geometry");
    int tid_l = threadIdx.x; asm volatile("" : "+v"(tid_l));
    const int tid = tid_l, lane = tid & 63, r32 = lane & 31, h = lane >> 5;
    const int wid = __builtin_amdgcn_readfirstlane(tid >> 6);
    LAS float* wsf = (LAS float*)(lds + WSF_OFF) + wid * 32;
    const LAS float* tab = (const LAS float*)(lds + TAB_OFF);
#pragma unroll
    for (int db = 0; db < 4; ++db)
#pragma unroll
        for (int r = 0; r < 16; ++r) O[db][r] = 0.f;
    if (t1 <= t0) return;
    bf16x8 Q[NKS];
#pragma unroll
    for (int ks = 0; ks < NKS; ++ks) Q[ks] = *(const bf16x8*)(qptr + (size_t)r32 * qpitch + ks * 16 + 8 * h);
    float mhat = NEG, lsum = 0.f;
    u32x4 kreg[KCH], vreg[VCH];
#define ATT_LOAD(t) do { int tv_ = tid; asm volatile("" : "+v"(tv_)); const bool c0_ = (t) < split; const int pt_ = c0_ ? pitch0 : pitch1; \
        const bf16_t* kt_ = c0_ ? kb0 + (size_t)(t) * TK * pitch0 : kb1 + (size_t)((t) - split) * TK * pitch1; \
        const bf16_t* vt_ = c0_ ? vb0 + (size_t)(t) * TK * pitch0 : vb1 + (size_t)((t) - split) * TK * pitch1; \
        _Pragma("unroll") for (int j_ = 0; j_ < KCH; ++j_) { const int c_ = tv_ + j_ * 512; kreg[j_] = *(const u32x4*)(kt_ + (size_t)(c_ / KCPR) * pt_ + (c_ % KCPR) * 8); } \
        _Pragma("unroll") for (int j_ = 0; j_ < VCH; ++j_) { const int c_ = tv_ + j_ * 512; vreg[j_] = *(const u32x4*)(vt_ + (size_t)(c_ >> 4) * pt_ + (c_ & 15) * 8); } } while (0)
#define ATT_STORE(buf) do { int tv_ = tid; asm volatile("" : "+v"(tv_)); LAS unsigned char* sb_ = lds + (buf) * STAGE; \
        _Pragma("unroll") for (int j_ = 0; j_ < KCH; ++j_) { const int c_ = tv_ + j_ * 512; *(LAS u32x4*)(sb_ + ((c_ / KCPR) * KP + (c_ % KCPR) * 8) * 2) = kreg[j_]; } \
        _Pragma("unroll") for (int j_ = 0; j_ < VCH; ++j_) { const int c_ = tv_ + j_ * 512; *(LAS u32x4*)(sb_ + KBYTES + ((c_ >> 4) * VP + (c_ & 15) * 8) * 2) = vreg[j_]; } } while (0)
    ATT_LOAD(t0); ATT_STORE(0);
    __syncthreads();
    for (int t = t0; t < t1; ++t) {
        const int buf = (t - t0) & 1; const bool more = t + 1 < t1;
        if (more) ATT_LOAD(t + 1);
        if (t >= wt0 && t < wt1) {
            const LAS unsigned char* Kb = lds + buf * STAGE; const LAS unsigned char* Vb = Kb + KBYTES;
            int lv = lane; asm volatile("" : "+v"(lv));
            const int r32 = lv & 31, h = lv >> 5, q4 = (lv & 15) >> 2, p4 = lv & 3, bc = (lv >> 4) & 1;
            const LAS unsigned char* Kl = Kb + (r32 * KP + 8 * h) * 2;
            const LAS unsigned char* Vl = Vb + ((4 * h + q4) * VP + 16 * bc) * 2 + 8 * p4;
            f32x16 S[NB];
            bool uni = false; float ci = 0.f;
            if constexpr (MODE == 1) { uni = (t <= cwrel); ci = uni ? tab[0] : 0.f; }
#pragma unroll
            for (int blk = 0; blk < NB; ++blk) {
#pragma unroll
                for (int r = 0; r < 16; ++r) S[blk][r] = ci;
#pragma unroll
                for (int ks = 0; ks < NKS; ++ks) {
                    const bf16x8 kf = *(const LAS bf16x8*)(Kl + (blk * 32 * KP + ks * 16) * 2);
                    S[blk] = __builtin_amdgcn_mfma_f32_32x32x16_bf16(kf, Q[ks], S[blk], 0, 0, 0);
                }
                __builtin_amdgcn_sched_barrier(0);
            }
            if constexpr (MODE == 0) {
                const float kb = (float)(kpos0 + t * TK + 4 * h - qpos);
#pragma unroll
                for (int blk = 0; blk < NB; ++blk)
#pragma unroll
                    for (int r = 0; r < 16; ++r) { const float d = kb + (float)(blk * 32 + (r & 3) + 8 * (r >> 2)); S[blk][r] -= modc * __builtin_fabsf(d); }
            }
            if constexpr (MODE == 1) {
                if (!uni) {
                    const int kb = kpos0 + t * TK + 4 * h - qpos;
#pragma unroll
                    for (int blk = 0; blk < NB; ++blk)
#pragma unroll
                        for (int r = 0; r < 16; ++r) { int d = kb + blk * 32 + (r & 3) + 8 * (r >> 2); d = min(max(d, -128), 128) + 128; S[blk][r] += tab[d]; }
                }
            }
            if constexpr (MASKK) {
                const int kb = t * TK + 4 * h;
#pragma unroll
                for (int blk = 0; blk < NB; ++blk)
#pragma unroll
                    for (int r = 0; r < 16; ++r) if (kb + blk * 32 + (r & 3) + 8 * (r >> 2) >= nkeys) S[blk][r] = NEG;
            }
            float rm = S[0][0];
#pragma unroll
            for (int blk = 0; blk < NB; ++blk)
#pragma unroll
                for (int r = 0; r < 16; ++r) rm = fmaxf(rm, S[blk][r]);
            rm = xmax32(rm);
            __builtin_amdgcn_sched_barrier(0);
            if (__any(rm > mhat + 8.f)) {
                const float mnew = fmaxf(mhat, rm), al = __builtin_amdgcn_exp2f(mhat - mnew);
                mhat = mnew; lsum *= al; wsf[r32] = al;
#pragma unroll
                for (int r = 0; r < 16; ++r) { const float a = wsf[crow(r, h)];
#pragma unroll
                    for (int db = 0; db < 4; ++db) O[db][r] *= a; }
            }
#pragma unroll
            for (int blk = 0; blk < NB; ++blk)
#pragma unroll
                for (int r = 0; r < 16; ++r) { const float p = __builtin_amdgcn_exp2f(S[blk][r] - mhat); lsum += p; S[blk][r] = p; }
            __builtin_amdgcn_sched_barrier(0);
#pragma unroll
            for (int blk = 0; blk < NB; ++blk)
#pragma unroll
                for (int s2 = 0; s2 < 2; ++s2) {
                    u32x4 pw; pw.x = pg8::cvt_pk_bf16(S[blk][8 * s2 + 0], S[blk][8 * s2 + 1]); pw.y = pg8::cvt_pk_bf16(S[blk][8 * s2 + 2], S[blk][8 * s2 + 3]);
                    pw.z = pg8::cvt_pk_bf16(S[blk][8 * s2 + 4], S[blk][8 * s2 + 5]); pw.w = pg8::cvt_pk_bf16(S[blk][8 * s2 + 6], S[blk][8 * s2 + 7]);
                    const bf16x8 pa = __builtin_bit_cast(bf16x8, pw);
#pragma unroll
                    for (int db = 0; db < 4; ++db) {
                        const LAS unsigned char* vp = Vl + ((32 * blk + 16 * s2) * VP + 32 * db) * 2;
                        const s16x4 lo = vtr(vp), hi = vtr(vp + 8 * VP * 2);
                        const bf16x8 vf = {lo[0], lo[1], lo[2], lo[3], hi[0], hi[1], hi[2], hi[3]};
                        O[db] = __builtin_amdgcn_mfma_f32_32x32x16_bf16(pa, vf, O[db], 0, 0, 0);
                    }
                    __builtin_amdgcn_sched_barrier(0);
                }
        }
        if (more) ATT_STORE(buf ^ 1);
        __syncthreads();
    }
#undef ATT_LOAD
#undef ATT_STORE
    if (wt1 > wt0) {
        lsum = xadd32(lsum);
        wsf[r32] = 1.0f / lsum;
#pragma unroll
        for (int r = 0; r < 16; ++r) { const float a = wsf[crow(r, h)];
#pragma unroll
            for (int db = 0; db < 4; ++db) O[db][r] *= a; }
    }
}


template <int NKS, int NB, int MODE, bool MASKK>
__device__ __forceinline__ void attn_pass_pipe(LAS unsigned char* lds, const bf16_t* qptr, int qpitch,
        const bf16_t* kb0, const bf16_t* vb0, int pitch0, const bf16_t* kb1, const bf16_t* vb1, int pitch1, int split,
        int t0, int t1, int wt0, int wt1, int qpos, int kpos0, float modc, int cwrel, int nkeys, f32x16 (&O)[4]) {
    constexpr int TK = 32 * NB, KP = NKS * 16 + 8, VP = 160;
    constexpr int KBYTES = TK * KP * 2, VBYTES = TK * VP * 2;
    constexpr int KCPR = NKS * 2, KCH = TK * KCPR / 512, VCH = TK * 16 / 512;
    static_assert(KCH >= 1 && VCH >= 1 && 2 * (KBYTES + VBYTES) <= WSF_OFF, "attention tile geometry");
    int tid_l = threadIdx.x; asm volatile("" : "+v"(tid_l));
    const int tid = tid_l, lane = tid & 63, r32o = lane & 31, ho = lane >> 5;
    const int wid = __builtin_amdgcn_readfirstlane(tid >> 6);
    LAS float* wsf = (LAS float*)(lds + WSF_OFF) + wid * 32;
    const LAS float* tab = (const LAS float*)(lds + TAB_OFF);
#pragma unroll
    for (int db = 0; db < 4; ++db)
#pragma unroll
        for (int r = 0; r < 16; ++r) O[db][r] = 0.f;
    if (t1 <= t0) return;
    bf16x8 Q[NKS];
#pragma unroll
    for (int ks = 0; ks < NKS; ++ks) Q[ks] = *(const bf16x8*)(qptr + (size_t)r32o * qpitch + ks * 16 + 8 * ho);
    float mhat = NEG, lsum = 0.f;
    u32x4 krA[KCH], vrA[VCH], krB[KCH], vrB[VCH];
#define APP_LOADK(t, kreg) do { int tv_ = tid; asm volatile("" : "+v"(tv_)); const bool c0_ = (t) < split; const int pt_ = c0_ ? pitch0 : pitch1; \
        const bf16_t* kt_ = c0_ ? kb0 + (size_t)(t) * TK * pitch0 : kb1 + (size_t)((t) - split) * TK * pitch1; \
        _Pragma("unroll") for (int j_ = 0; j_ < KCH; ++j_) { const int c_ = tv_ + j_ * 512; kreg[j_] = *(const u32x4*)(kt_ + (size_t)(c_ / KCPR) * pt_ + (c_ % KCPR) * 8); } } while (0)
#define APP_LOADV(t, vreg) do { int tv_ = tid; asm volatile("" : "+v"(tv_)); const bool c0_ = (t) < split; const int pt_ = c0_ ? pitch0 : pitch1; \
        const bf16_t* vt_ = c0_ ? vb0 + (size_t)(t) * TK * pitch0 : vb1 + (size_t)((t) - split) * TK * pitch1; \
        _Pragma("unroll") for (int j_ = 0; j_ < VCH; ++j_) { const int c_ = tv_ + j_ * 512; vreg[j_] = *(const u32x4*)(vt_ + (size_t)(c_ >> 4) * pt_ + (c_ & 15) * 8); } } while (0)
#define APP_STOREK(p, kreg) do { int tv_ = tid; asm volatile("" : "+v"(tv_)); LAS unsigned char* sb_ = lds + (p) * KBYTES; \
        _Pragma("unroll") for (int j_ = 0; j_ < KCH; ++j_) { const int c_ = tv_ + j_ * 512; *(LAS u32x4*)(sb_ + ((c_ / KCPR) * KP + (c_ % KCPR) * 8) * 2) = kreg[j_]; } } while (0)
#define APP_STOREV(p, vreg) do { int tv_ = tid; asm volatile("" : "+v"(tv_)); LAS unsigned char* sb_ = lds + 2 * KBYTES + (p) * VBYTES; \
        _Pragma("unroll") for (int j_ = 0; j_ < VCH; ++j_) { const int c_ = tv_ + j_ * 512; *(LAS u32x4*)(sb_ + ((c_ >> 4) * VP + (c_ & 15) * 8) * 2) = vreg[j_]; } } while (0)
#define APP_QK(Sx, t_) do { const LAS unsigned char* Kb_ = lds + (((t_) - t0) & 1) * KBYTES; int lv_ = lane; asm volatile("" : "+v"(lv_)); \
        const LAS unsigned char* Kl_ = Kb_ + ((lv_ & 31) * KP + 8 * (lv_ >> 5)) * 2; float ci_ = 0.f; if constexpr (MODE == 1) { ci_ = ((t_) <= cwrel) ? tab[0] : 0.f; } \
        __builtin_amdgcn_s_setprio(1); \
        _Pragma("unroll") for (int blk = 0; blk < NB; ++blk) { _Pragma("unroll") for (int r = 0; r < 16; ++r) Sx[blk][r] = ci_; \
            _Pragma("unroll") for (int ks = 0; ks < NKS; ++ks) { const bf16x8 kf_ = *(const LAS bf16x8*)(Kl_ + (blk * 32 * KP + ks * 16) * 2); Sx[blk] = __builtin_amdgcn_mfma_f32_32x32x16_bf16(kf_, Q[ks], Sx[blk], 0, 0, 0); } } \
        __builtin_amdgcn_s_setprio(0); } while (0)
#define APP_SMPV(Sx, t_) do { const LAS unsigned char* Vb_ = lds + 2 * KBYTES + (((t_) - t0) & 1) * VBYTES; int lv_ = lane; asm volatile("" : "+v"(lv_)); \
        const int r32 = lv_ & 31, h = lv_ >> 5, q4 = (lv_ & 15) >> 2, p4 = lv_ & 3, bc = (lv_ >> 4) & 1; \
        const LAS unsigned char* Vl = Vb_ + ((4 * h + q4) * VP + 16 * bc) * 2 + 8 * p4; \
        if constexpr (MODE == 0) { const float kb = (float)(kpos0 + (t_) * TK + 4 * h - qpos); \
            _Pragma("unroll") for (int blk = 0; blk < NB; ++blk) _Pragma("unroll") for (int r = 0; r < 16; ++r) { const float d = kb + (float)(blk * 32 + (r & 3) + 8 * (r >> 2)); Sx[blk][r] -= modc * __builtin_fabsf(d); } } \
        if constexpr (MODE == 1) { if (!((t_) <= cwrel)) { const int kb = kpos0 + (t_) * TK + 4 * h - qpos; \
            _Pragma("unroll") for (int blk = 0; blk < NB; ++blk) _Pragma("unroll") for (int r = 0; r < 16; ++r) { int d = kb + blk * 32 + (r & 3) + 8 * (r >> 2); d = min(max(d, -128), 128) + 128; Sx[blk][r] += tab[d]; } } } \
        if constexpr (MASKK) { const int kb = (t_) * TK + 4 * h; \
            _Pragma("unroll") for (int blk = 0; blk < NB; ++blk) _Pragma("unroll") for (int r = 0; r < 16; ++r) if (kb + blk * 32 + (r & 3) + 8 * (r >> 2) >= nkeys) Sx[blk][r] = NEG; } \
        float rm = Sx[0][0]; \
        _Pragma("unroll") for (int blk = 0; blk < NB; ++blk) _Pragma("unroll") for (int r = 0; r < 16; ++r) rm = fmaxf(rm, Sx[blk][r]); \
        rm = xmax32(rm); \
        if (__any(rm > mhat + 8.f)) { const float mnew = fmaxf(mhat, rm), al = __builtin_amdgcn_exp2f(mhat - mnew); mhat = mnew; lsum *= al; wsf[r32] = al; \
            _Pragma("unroll") for (int r = 0; r < 16; ++r) { const float a_ = wsf[crow(r, h)]; _Pragma("unroll") for (int db = 0; db < 4; ++db) O[db][r] *= a_; } } \
        _Pragma("unroll") for (int blk = 0; blk < NB; ++blk) _Pragma("unroll") for (int r = 0; r < 16; ++r) { const float p = __builtin_amdgcn_exp2f(Sx[blk][r] - mhat); lsum += p; Sx[blk][r] = p; } \
        __builtin_amdgcn_sched_barrier(0); __builtin_amdgcn_s_setprio(1); \
        _Pragma("unroll") for (int blk = 0; blk < NB; ++blk) _Pragma("unroll") for (int s2 = 0; s2 < 2; ++s2) { \
            u32x4 pw; pw.x = pg8::cvt_pk_bf16(Sx[blk][8 * s2 + 0], Sx[blk][8 * s2 + 1]); pw.y = pg8::cvt_pk_bf16(Sx[blk][8 * s2 + 2], Sx[blk][8 * s2 + 3]); \
            pw.z = pg8::cvt_pk_bf16(Sx[blk][8 * s2 + 4], Sx[blk][8 * s2 + 5]); pw.w = pg8::cvt_pk_bf16(Sx[blk][8 * s2 + 6], Sx[blk][8 * s2 + 7]); \
            const bf16x8 pa = __builtin_bit_cast(bf16x8, pw); \
            _Pragma("unroll") for (int db = 0; db < 4; ++db) { const LAS unsigned char* vp = Vl + ((32 * blk + 16 * s2) * VP + 32 * db) * 2; \
                const s16x4 lo = vtr(vp), hi = vtr(vp + 8 * VP * 2); const bf16x8 vf = {lo[0], lo[1], lo[2], lo[3], hi[0], hi[1], hi[2], hi[3]}; \
                O[db] = __builtin_amdgcn_mfma_f32_32x32x16_bf16(pa, vf, O[db], 0, 0, 0); } \
            __builtin_amdgcn_sched_barrier(0); } __builtin_amdgcn_s_setprio(0); } while (0)
#define APP_STEP(Sc, Sn, t_, KL, VL, KS, VS) do { \
        if ((t_) + 3 < t1) APP_LOADK((t_) + 3, KL); if ((t_) + 2 < t1) APP_LOADV((t_) + 2, VL); \
        if ((t_) + 1 >= wt0 && (t_) + 1 < wt1) APP_QK(Sn, (t_) + 1); \
        __builtin_amdgcn_sched_barrier(0); \
        if ((t_) >= wt0 && (t_) < wt1) APP_SMPV(Sc, t_); \
        if ((t_) + 2 < t1) APP_STOREK(((t_) - t0) & 1, KS); if ((t_) + 1 < t1) APP_STOREV((((t_) - t0) + 1) & 1, VS); \
        __syncthreads(); } while (0)
    f32x16 Sa[NB], Sb[NB];
    APP_LOADK(t0, krA); APP_LOADV(t0, vrA); APP_STOREK(0, krA); APP_STOREV(0, vrA);
    if (t0 + 1 < t1) { APP_LOADK(t0 + 1, krA); APP_STOREK(1, krA); }
    if (t0 + 2 < t1) APP_LOADK(t0 + 2, krB); if (t0 + 1 < t1) APP_LOADV(t0 + 1, vrB);
    __syncthreads();
    if (t0 >= wt0 && t0 < wt1) APP_QK(Sa, t0);
    __syncthreads();
    for (int t = t0; t < t1;) {
        APP_STEP(Sa, Sb, t, krA, vrA, krB, vrB); ++t; if (t >= t1) break;
        APP_STEP(Sb, Sa, t, krB, vrB, krA, vrA); ++t;
    }
#undef APP_LOADK
#undef APP_LOADV
#undef APP_STOREK
#undef APP_STOREV
#undef APP_QK
#undef APP_SMPV
#undef APP_STEP
    if (wt1 > wt0) {
        lsum = xadd32(lsum);
        wsf[r32o] = 1.0f / lsum;
#pragma unroll
        for (int r = 0; r < 16; ++r) { const float a = wsf[crow(r, ho)];
#pragma unroll
            for (int db = 0; db < 4; ++db) O[db][r] *= a; }
    }
}

struct Ptrs {
    const bf16_t* QKV; bf16_t* OB; const bf16_t *MKp, *MVp, *KAc, *VAc, *KBc, *VBc, *MKc, *MVc;
    const float *relb, *subln; float lam;
};
__device__ __forceinline__ void store_o(const f32x16 (&O)[4], bf16_t* dst, int nrows, int lane) {
    const int r32 = lane & 31, h = lane >> 5;
    const unsigned lo = (unsigned)((4 * h * 3072 + r32) * 2);
#pragma unroll
    for (int r = 0; r < 16; ++r) { const int row = crow(r, h);
        unsigned o = lo + (unsigned)(((r & 3) + 8 * (r >> 2)) * 6144); asm volatile("" : "+v"(o));
        unsigned char* p = (unsigned char*)dst + o;
        if (row < nrows) {
#pragma unroll
            for (int db = 0; db < 4; ++db) *(bf16_t*)(p + 64 * db) = f2bf(O[db][r]); } }
}
template <bool SAMPLE> __device__ __forceinline__ void unit_a(LAS unsigned char* lds, const Ptrs& P, int b, int head, int qb) {
    int tid_l = threadIdx.x; asm volatile("" : "+v"(tid_l));
    const int tid = tid_l, lane = tid & 63, r32 = lane & 31, h = lane >> 5, wid = __builtin_amdgcn_readfirstlane(tid >> 6);
    const size_t rowbase = SAMPLE ? (size_t)MP + b * 16 : (size_t)b * 2048 + qb * 256 + wid * 32;
    const float modc = __builtin_amdgcn_exp2f(-(float)(head + 1)) * LOG2E;
    const bool active = SAMPLE ? (wid == 0) : true;
    const int nrows = SAMPLE ? 16 : 32;
    bf16_t* ob = P.OB + rowbase * 3072 + head * 128;
    f32x16 O[4];
#pragma unroll 1
    for (int map = 0; map < 2; ++map) {
        const bf16_t* qptr = P.QKV + rowbase * NQKV + head * 128 + map * 64;
        if constexpr (SAMPLE) {
            const bf16_t* kb0 = P.KAc + (size_t)b * 1024 * 1024 + head * 128 + map * 64; const bf16_t* vb0 = P.VAc + (size_t)b * 1024 * 1024 + head * 128;
            const bf16_t* kb1 = P.QKV + rowbase * NQKV + 1024 + head * 128 + map * 64; const bf16_t* vb1 = P.QKV + rowbase * NQKV + 2048 + head * 128;
            attn_pass<4, 2, 0, true>(lds, qptr, NQKV, kb0, vb0, 1024, kb1, vb1, NQKV, 16, 0, 17, 0, active ? 17 : 0, 1024 + r32, 0, modc, 0, 1040, O);
        } else {
            const bf16_t* kb0 = P.QKV + (size_t)b * 2048 * NQKV + 1024 + head * 128 + map * 64; const bf16_t* vb0 = P.QKV + (size_t)b * 2048 * NQKV + 2048 + head * 128;
            attn_pass_pipe<4, 2, 0, false>(lds, qptr, NQKV, kb0, vb0, NQKV, kb0, vb0, NQKV, 1 << 30, 0, 4 * qb + 4, 0, 4 * qb + (wid >> 1) + 1, qb * 256 + wid * 32 + r32, 0, modc, 0, 0, O);
        }
        if (active) {
            if (map == 0) store_o(O, ob, nrows, lane);
            else {
                float gs[4];
#pragma unroll
                for (int db = 0; db < 4; ++db) gs[db] = P.subln[32 * db + r32] * 0.8f;
                const unsigned lo = (unsigned)((4 * h * 3072 + r32) * 2);
#pragma unroll
                for (int r = 0; r < 16; ++r) { const int row = crow(r, h); float ss = 0.f;
                    unsigned o = lo + (unsigned)(((r & 3) + 8 * (r >> 2)) * 6144); asm volatile("" : "+v"(o));
                    unsigned char* p = (unsigned char*)ob + o;
                    if (row < nrows) {
#pragma unroll
                        for (int db = 0; db < 4; ++db) { const float ov = bf2f(*(const bf16_t*)(p + 64 * db)) - P.lam * O[db][r]; O[db][r] = ov; ss += ov * ov; } }
#pragma unroll
                    for (int o_ = 1; o_ < 32; o_ <<= 1) ss += __shfl_xor(ss, o_);
                    const float rn = rsqrtf(ss * (1.0f / 128.0f) + EPS);
                    if (row < nrows) {
#pragma unroll
                        for (int db = 0; db < 4; ++db) *(bf16_t*)(p + 64 * db) = f2bf(O[db][r] * rn * gs[db]); }
                    asm volatile("" ::: "memory"); }
            }
        }
    }
}
template <bool SAMPLE> __device__ __forceinline__ void unit_b(LAS unsigned char* lds, const Ptrs& P, int b, int head, int qb) {
    int tid_l = threadIdx.x; asm volatile("" : "+v"(tid_l));
    const int tid = tid_l, lane = tid & 63, r32 = lane & 31, wid = __builtin_amdgcn_readfirstlane(tid >> 6);
    const size_t rowbase = SAMPLE ? (size_t)MP + b * 16 : (size_t)b * 2048 + qb * 256 + wid * 32;
    LAS float* tab = (LAS float*)(lds + TAB_OFF);
    if (tid < 257) tab[tid] = P.relb[head * 257 + tid] * LOG2E;
    const bf16_t* qptr = P.QKV + rowbase * NQKV + 3072 + head * 128;
    f32x16 O[4];
    if constexpr (SAMPLE) {
        const bool active = wid == 0;
        const bf16_t* kb0 = P.KBc + (size_t)b * 512 * 1024 + head * 128; const bf16_t* vb0 = P.VBc + (size_t)b * 512 * 1024 + head * 128;
        const bf16_t* kb1 = P.QKV + rowbase * NQKV + 4096 + head * 128; const bf16_t* vb1 = P.QKV + rowbase * NQKV + 5120 + head * 128;
        attn_pass<8, 2, 1, true>(lds, qptr, NQKV, kb0, vb0, 1024, kb1, vb1, NQKV, 8, 0, 9, 0, active ? 9 : 0, 1024 + r32, 512, 0.f, 5, 528, O);
        if (active) store_o(O, P.OB + rowbase * 3072 + 1024 + head * 128, 16, lane);
    } else {
        const int c0 = 4 * qb, cw = c0 + (wid >> 1);
        const bf16_t* kb0 = P.QKV + (size_t)b * 2048 * NQKV + 4096 + head * 128; const bf16_t* vb0 = P.QKV + (size_t)b * 2048 * NQKV + 5120 + head * 128;
        attn_pass<8, 2, 1, false>(lds, qptr, NQKV, kb0, vb0, NQKV, kb0, vb0, NQKV, 1 << 30, max(0, c0 - 8), c0 + 4, max(0, cw - 8), cw + 1, qb * 256 + wid * 32 + r32, 0, 0.f, cw - 3, 0, O);
        store_o(O, P.OB + rowbase * 3072 + 1024 + head * 128, 32, lane);
    }
}
template <bool SAMPLE> __device__ __forceinline__ void unit_c(LAS unsigned char* lds, const Ptrs& P, int b, int head, int qb) {
    int tid_l = threadIdx.x; asm volatile("" : "+v"(tid_l));
    const int tid = tid_l, lane = tid & 63, wid = __builtin_amdgcn_readfirstlane(tid >> 6);
    const size_t rowbase = SAMPLE ? (size_t)MP + b * 16 : (size_t)b * 2048 + qb * 256 + wid * 32;
    const bool active = SAMPLE ? (wid == 0) : true;
    const bf16_t* qptr = P.QKV + rowbase * NQKV + 6144 + head * 256;
    const bf16_t* kb = (SAMPLE ? P.MKc : P.MKp) + (size_t)b * 256 * 1024 + head * 256;
    const bf16_t* vb = (SAMPLE ? P.MVc : P.MVp) + (size_t)b * 256 * 1024 + head * 256;
    f32x16 O[4];
#pragma unroll 1
    for (int dh = 0; dh < 2; ++dh) {
        attn_pass<16, 1, 2, false>(lds, qptr, NQKV, kb, vb + dh * 128, 1024, kb, vb + dh * 128, 1024, 1 << 30, 0, 8, 0, active ? 8 : 0, 0, 0, 0.f, 0, 0, O);
        if (active) store_o(O, P.OB + rowbase * 3072 + 2048 + head * 256 + dh * 128, SAMPLE ? 16 : 32, lane);
    }
}
}
typedef unsigned short bf16;
typedef unsigned v4u __attribute__((ext_vector_type(4)));
typedef unsigned v2u __attribute__((ext_vector_type(2)));
typedef float f32x4 __attribute__((ext_vector_type(4)));
constexpr int NWAVES = 8;
#ifndef REP_P0
#define REP_P0 1
#endif
#ifndef REP_P5
#define REP_P5 1
#endif
#ifndef REP_A
#define REP_A 1
#endif
#ifndef REP_G1
#define REP_G1 1
#endif
#ifndef REP_G3
#define REP_G3 1
#endif
#ifndef REP_G4
#define REP_G4 1
#endif
#ifndef REP_G6
#define REP_G6 1
#endif
#ifndef REP_G7
#define REP_G7 1
#endif
#ifndef REP_P2
#define REP_P2 1
#endif
constexpr int LDS_BYTES = 147456;
#define LDS_WAIT() asm volatile("s_waitcnt lgkmcnt(0)" ::: "memory")
__device__ __forceinline__ unsigned pk2(float lo, float hi) { return pg8::cvt_pk_bf16(lo, hi); }
__device__ __forceinline__ float wave_sum(float v) {
#pragma unroll
    for (int o = 1; o < 64; o <<= 1) v += __shfl_xor(v, o);
    return v;
}
__device__ __forceinline__ void transpose_item(const float* W, int N, bf16* WT, int dpitch, int koff, int mode, LAS float* scr, int item, int lane) {
    const int nblk = N / 64, kb = item / nblk, nb = item % nblk, k0 = 64 * kb, n0 = 64 * nb;
    int d0 = n0;
    if (mode == 1) { const int isb = n0 >= DFF, n1 = isb ? n0 - DFF : n0; d0 = (n1 >> 7) * 256 + (n1 & 127) + (isb ? 128 : 0); }
    f32x4 v[16]; const int kr = lane >> 4, nn = (lane & 15) * 4;
    const float* wp = W + (size_t)(k0 + kr) * N + n0 + nn;
#pragma unroll
    for (int i = 0; i < 16; ++i) v[i] = __builtin_nontemporal_load((const f32x4*)(wp + (size_t)(4 * i) * N));
#pragma unroll
    for (int i = 0; i < 16; ++i) { LAS float* s = scr + (4 * i + kr) * 65 + nn; s[0] = v[i].x; s[1] = v[i].y; s[2] = v[i].z; s[3] = v[i].w; }
    LDS_WAIT(); asm volatile("" ::: "memory");
    const int c = lane & 7;
#pragma unroll
    for (int j = 0; j < 8; ++j) { const int n = (lane >> 3) + 8 * j; const LAS float* s = scr + (8 * c) * 65 + n;
        v4u o; o.x = pk2(s[0 * 65], s[1 * 65]); o.y = pk2(s[2 * 65], s[3 * 65]); o.z = pk2(s[4 * 65], s[5 * 65]); o.w = pk2(s[6 * 65], s[7 * 65]);
        *(v4u*)(WT + (size_t)(d0 + n) * dpitch + koff + k0 + 8 * c) = o; }
    LDS_WAIT(); asm volatile("" ::: "memory");
}
__device__ __forceinline__ void rms_rows_to_bf16(const float* src, const float* g, bf16* dst, int nrows, int w0, int nw, int lane) {
    f32x4 gg[8]; { const f32x4* gr = (const f32x4*)g + lane;
#pragma unroll
        for (int j = 0; j < 8; ++j) gg[j] = gr[64 * j]; }
    f32x4 va[8], vb[8];
#define RMS_LOAD(m_, V) do { const f32x4* xr_ = (const f32x4*)(src + (size_t)(m_) * DM) + lane; _Pragma("unroll") for (int j = 0; j < 8; ++j) V[j] = __builtin_nontemporal_load(xr_ + 64 * j); } while (0)
#define RMS_PROC(m_, V) do { float s_ = 0.f; _Pragma("unroll") for (int j = 0; j < 8; ++j) s_ += (V[j].x * V[j].x + V[j].y * V[j].y) + (V[j].z * V[j].z + V[j].w * V[j].w); \
        const float rs_ = rsqrtf(wave_sum(s_) * (1.f / DM) + EPS); v2u* o8_ = (v2u*)(dst + (size_t)(m_) * DM) + lane; \
        _Pragma("unroll") for (int j = 0; j < 8; ++j) { v2u w_; w_.x = pk2(V[j].x * rs_ * gg[j].x, V[j].y * rs_ * gg[j].y); w_.y = pk2(V[j].z * rs_ * gg[j].z, V[j].w * rs_ * gg[j].w); o8_[64 * j] = w_; } } while (0)
    int m = w0; if (m < nrows) RMS_LOAD(m, va);
    while (m < nrows) {
        if (m + nw < nrows) RMS_LOAD(m + nw, vb);
        __builtin_amdgcn_sched_barrier(0);
        RMS_PROC(m, va); m += nw; if (m >= nrows) break;
        if (m + nw < nrows) RMS_LOAD(m + nw, va);
        __builtin_amdgcn_sched_barrier(0);
        RMS_PROC(m, vb); m += nw;
    }
#undef RMS_LOAD
#undef RMS_PROC
}
__device__ __forceinline__ void zero_row_bf16(bf16* orow, int lane) { v2u* o8 = (v2u*)orow + lane; v2u z; z.x = 0u; z.y = 0u;
#pragma unroll
    for (int j = 0; j < 8; ++j) o8[64 * j] = z; }
__device__ __forceinline__ void cvt_f32_bf16(const float* src, bf16* dst, size_t n, size_t gt, size_t ngt) {
    for (size_t i = gt * 8; i < n; i += ngt * 32) {
        f32x4 a[4], b[4];
#pragma unroll
        for (int u = 0; u < 4; ++u) { const size_t k = i + (size_t)u * ngt * 8; if (k < n) { a[u] = __builtin_nontemporal_load((const f32x4*)(src + k)); b[u] = __builtin_nontemporal_load((const f32x4*)(src + k + 4)); } }
#pragma unroll
        for (int u = 0; u < 4; ++u) { const size_t k = i + (size_t)u * ngt * 8; if (k < n) { v4u o; o.x = pk2(a[u].x, a[u].y); o.y = pk2(a[u].z, a[u].w); o.z = pk2(b[u].x, b[u].y); o.w = pk2(b[u].z, b[u].w); *(v4u*)(dst + k) = o; } }
    }
}
__device__ __forceinline__ f32x4 unpk4(v2u w) { f32x4 r; r.x = __uint_as_float(w.x << 16); r.y = __uint_as_float(w.x & 0xffff0000u); r.z = __uint_as_float(w.y << 16); r.w = __uint_as_float(w.y & 0xffff0000u); return r; }
#define RLX_AGENT __ATOMIC_RELAXED, __HIP_MEMORY_SCOPE_AGENT
#define XB_TMO      128
#define XB_XCNT(j)  (256  + 64 * (j))
#define XB_XSUB(j)  (1280 + 64 * (j))
#define XB_XGEN(j)  (2304 + 64 * (j))
#define XB_TOP      3328
#define XB_TOPGEN   3392
#define XCD_BAR_WORDS 3456
#define XB_SPIN_CAP (1u << 18)

__device__ __forceinline__ unsigned xb_ld(unsigned* p)              { return __hip_atomic_load(p, __ATOMIC_RELAXED, __HIP_MEMORY_SCOPE_AGENT); }
__device__ __forceinline__ unsigned xb_add(unsigned* p, unsigned v) { return __hip_atomic_fetch_add(p, v, __ATOMIC_RELAXED, __HIP_MEMORY_SCOPE_AGENT); }
__device__ __forceinline__ unsigned xb_xcc_id() { return (unsigned)__builtin_amdgcn_s_getreg((3 << 11) | 20) & 0xFu; }
#define XB_SPIN(cond, bar) do { unsigned _sp = 0; while (cond) { __builtin_amdgcn_s_sleep(1); \
    if ((++_sp & 255u) == 0u) { if (xb_ld(&(bar)[XB_TMO])) break; if (_sp > XB_SPIN_CAP) { atomicAdd(&(bar)[XB_TMO], 1u); break; } } } } while (0)

struct XcdBarrier {
    unsigned* bar; unsigned x;
    volatile LAS unsigned* st;
};

__device__ __forceinline__ XcdBarrier xcd_barrier_post(unsigned* bar, volatile LAS unsigned* st) {
    XcdBarrier b; b.bar = bar; b.x = xb_xcc_id(); b.st = st;
    if (threadIdx.x == 0) (void)xb_add(&bar[XB_XCNT(b.x)], 1u);
    return b;
}
__device__ __forceinline__ void xcd_barrier_complete(unsigned* bar, unsigned x, unsigned& nloc, unsigned& nx) {
    const unsigned G = gridDim.x * gridDim.y * gridDim.z;
    unsigned sum, cnt, mine, sp = 0u;
    for (;;) {
        sum = 0u; cnt = 0u; mine = 0u;
#pragma unroll
        for (unsigned j = 0; j < 16; ++j) { const unsigned c = xb_ld(&bar[XB_XCNT(j)]); sum += c; cnt += (c > 0u) ? 1u : 0u; mine = (j == x) ? c : mine; }
        if (sum == G) break;
        __builtin_amdgcn_s_sleep(1);
        if ((++sp & 255u) == 0u) { if (xb_ld(&bar[XB_TMO])) break; if (sp > XB_SPIN_CAP) { atomicAdd(&bar[XB_TMO], 1u); break; } }
    }
    nloc = mine > 0u ? mine : 1u; nx = cnt > 0u ? cnt : 1u;
}

__device__ __forceinline__ void xcd_barrier(const XcdBarrier& b) {
    asm volatile("s_waitcnt vmcnt(0)" ::: "memory");
    __syncthreads();
    if (threadIdx.x == 0) {
        unsigned* bar = b.bar;
        __builtin_amdgcn_s_waitcnt(0);
        unsigned nloc = b.st[0], nx = b.st[1];
        if (nloc == 0u) { xcd_barrier_complete(bar, b.x, nloc, nx); b.st[0] = nloc; b.st[1] = nx; }
        const unsigned old = xb_add(&bar[XB_XSUB(b.x)], 1u);
        const unsigned gen = old / nloc;
        if (old + 1u == (gen + 1u) * nloc) {
            __builtin_amdgcn_fence(__ATOMIC_RELEASE, "agent");
            asm volatile("s_waitcnt vmcnt(0)" ::: "memory");
            const unsigned og = xb_add(&bar[XB_TOP], 1u);
            const unsigned tg = og / nx;
            if (og + 1u == (tg + 1u) * nx) xb_add(&bar[XB_TOPGEN], 1u);
            else XB_SPIN(xb_ld(&bar[XB_TOPGEN]) == tg, bar);
            __builtin_amdgcn_fence(__ATOMIC_ACQUIRE, "agent");
            xb_add(&bar[XB_XGEN(b.x)], 1u);
            asm volatile("s_waitcnt vmcnt(0)" ::: "memory");
        } else {
            XB_SPIN(xb_ld(&bar[XB_XGEN(b.x)]) == gen, bar);
            __builtin_amdgcn_fence(__ATOMIC_ACQUIRE, "agent");
            asm volatile("s_waitcnt vmcnt(0)" ::: "memory");
        }
    }
    __syncthreads();
}

struct Args { const float* in[29]; float* out; unsigned char* ws; };
enum { I_XP = 0, I_XS, I_CAK, I_CAV, I_CBK, I_CBV, I_CMK, I_CMV, I_MEM, I_NMIXPRE, I_NMIXPOST, I_NMEM, I_WIN, I_BGATE, I_LQ1, I_LK1, I_LQ2, I_LK2, I_SUBLN, I_RELB,
       I_WMEM, I_WBRA, I_WBRB, I_WBRC, I_WOUT, I_NFFPRE, I_NFFPOST, I_WFFI, I_WFFO };

__global__ void __launch_bounds__(NWAVES * 64, 2) fwd_megakernel(Args a) {
    extern __shared__ __attribute__((aligned(16))) unsigned char lds_raw[];
    cg::grid_group grid = cg::this_grid();
    LAS unsigned char* lds = (LAS unsigned char*)lds_raw;
#define FRESH_TID() int tid_l = threadIdx.x; asm volatile("" : "+v"(tid_l)); const int tid = tid_l, lane = tid & 63; (void)lane;
    const int wave = __builtin_amdgcn_readfirstlane((int)threadIdx.x >> 6);
    const int G = gridDim.x, bx = blockIdx.x, vcu = (G % 8 == 0) ? (bx % 8) * (G / 8) + bx / 8 : bx;
    unsigned char* ws = a.ws; unsigned char* ys = (unsigned char*)a.out;
    bf16* Win_t = (bf16*)(ws + WS_WIN); bf16* Wmem_t = (bf16*)(ws + WS_WMEM); bf16* Wbr_t = (bf16*)(ws + WS_WBR); bf16* Wout_t = (bf16*)(ws + WS_WOUT);
    bf16* Wffi_t = (bf16*)(ws + WS_WFFI); bf16* Wffo_t = (bf16*)(ws + WS_WFFO);
    bf16* QKV = (bf16*)(ws + WS_QKV); bf16* GT = (bf16*)(ws + WS_G); bf16* MEMN = (bf16*)(ws + WS_MEMN); bf16* MKp = (bf16*)(ws + WS_MKP); bf16* MVp = (bf16*)(ws + WS_MVP);
    bf16* MERGED = (bf16*)(ws + WS_MERGED); bf16* T = (bf16*)(ws + WS_T); bf16* ACT = (bf16*)(ws + WS_ACT); bf16* X1 = (bf16*)(ws + WS_X1); bf16* UB = (bf16*)(ws + WS_H2);       bf16* H2 = (bf16*)(ws + WS_H2);
    bf16* PSB = (bf16*)(ws + WS_PS); float* TS = (float*)(ws + WS_TS); float* US = (float*)(ws + WS_US);
    bf16* XN = (bf16*)(ys + YS_XN); bf16* OB = (bf16*)(ys + YS_OB);
    bf16* KAc = (bf16*)(ys + YS_KAC); bf16* VAc = (bf16*)(ys + YS_VAC); bf16* KBc = (bf16*)(ys + YS_KBC); bf16* VBc = (bf16*)(ys + YS_VBC); bf16* MKc = (bf16*)(ys + YS_MKC); bf16* MVc = (bf16*)(ys + YS_MVC);
    const int gw = vcu * NWAVES + wave, NGW = G * NWAVES;
    volatile LAS unsigned* bst = (volatile LAS unsigned*)(lds + 147392);
    if (threadIdx.x < 2) bst[threadIdx.x] = 0u;
    __syncthreads();
    const XcdBarrier xbar = xcd_barrier_post((unsigned*)(ws + WS_CTL), bst);
    unsigned* xrank = (unsigned*)(ws + WS_CTL) + 3584;
    if (threadIdx.x == 0) bst[2] = __hip_atomic_fetch_add(xrank + 16 * xbar.x, 1u, __ATOMIC_RELAXED, __HIP_MEMORY_SCOPE_AGENT);
    __syncthreads();

#pragma unroll 1
    for (int rep0 = 0; rep0 < REP_P0; ++rep0) {
        FRESH_TID();
        LAS float* scr = (LAS float*)(lds + wave * 16640);
        const size_t gt = (size_t)vcu * 512 + tid, ngt = (size_t)G * 512;
        cvt_f32_bf16(a.in[I_CAK], KAc, 8388608, gt, ngt); cvt_f32_bf16(a.in[I_CAV], VAc, 8388608, gt, ngt);
        cvt_f32_bf16(a.in[I_CBK], KBc, 4194304, gt, ngt); cvt_f32_bf16(a.in[I_CBV], VBc, 4194304, gt, ngt);
        cvt_f32_bf16(a.in[I_CMK], MKc, 2097152, gt, ngt); cvt_f32_bf16(a.in[I_CMV], MVc, 2097152, gt, ngt);
        constexpr int I_IN = 32 * (NIN / 64), I_ME = 32 * 32;
        constexpr int NITEMS = I_IN + I_ME;
        for (int it = gw; it < NITEMS; it += NGW) {
            if (it < I_IN) transpose_item(a.in[I_WIN], NIN, Win_t, DM, 0, 0, scr, it, lane);
            else transpose_item(a.in[I_WMEM], DM, Wmem_t, DM, 0, 0, scr, it - I_IN, lane);
        }
        rms_rows_to_bf16(a.in[I_XP], a.in[I_NMIXPRE], XN, MP, gw, NGW, lane);
        rms_rows_to_bf16(a.in[I_MEM], a.in[I_NMEM], MEMN, NMEMROWS, gw, NGW, lane);
        rms_rows_to_bf16(a.in[I_XS], a.in[I_NMIXPRE], XN + (size_t)MP * DM, MS, gw, NGW, lane);
        for (int m = MP + MS + gw; m < MT; m += NGW) zero_row_bf16(XN + (size_t)m * DM, lane);
    }
    if (a.ws == nullptr) grid.sync();
    xcd_barrier(xbar);
    int vc = bx;
    { bool ok = (G % 8 == 0); unsigned mine = 0;
#pragma unroll 1
      for (unsigned j = 0; j < 16; ++j) { const unsigned cnt = __hip_atomic_load(xrank + 16 * j, __ATOMIC_RELAXED, __HIP_MEMORY_SCOPE_AGENT); if (j < 8 ? cnt != (unsigned)(G / 8) : cnt != 0u) ok = false; if (j == xbar.x) mine = cnt; }
      (void)mine;
      if (ok) vc = (int)bst[2] * 8 + (int)xbar.x; }
    vc = __builtin_amdgcn_readfirstlane(vc);
    const int vcu2 = (G % 8 == 0) ? (vc % 8) * (G / 8) + vc / 8 : vc;
#pragma unroll 1
    for (int rg = 0; rg < REP_G1; ++rg) {
        pg8::Gemm g{nullptr, nullptr, 0, 0, DM}; pg8::PhaseSched S; S.so.init(MP, NIN, G, vc); S.n0 = 128 * 52; S.n1 = 52 + 128; S.G = G; S.c = vc; S.mode = 1; S.nt0 = 32;
        S.A0 = (const char*)XN; S.B0 = (const char*)Win_t; S.A1 = (const char*)MEMN; S.B1 = (const char*)Wmem_t;
        pg8::EpiP1 E{pg8::EpiQKV{QKV, GT, a.in[I_BGATE], a.out}, pg8::EpiMem{MKp, MVp, a.out}};
        pg8::gemm_phase<pg8::EpiP1, pg8::PhaseSched, true, true>(lds, g, S, E);
        if (G == 256 ? vc >= 180 : true) {
            FRESH_TID(); LAS float* scr = (LAS float*)(lds + wave * 16640);
            constexpr int I_BR = 16 * 32, I_OU = 32 * 32, NIT = 3 * I_BR + I_OU;
            const int nwg = G == 256 ? 76 : G, w0 = G == 256 ? vc - 180 : vc;
            for (int it = w0 * NWAVES + wave; it < NIT; it += nwg * NWAVES) {
                int r = it;
                if (r < I_BR) { transpose_item(a.in[I_WBRA], DM, Wbr_t, 3072, 0, 0, scr, r, lane); continue; } r -= I_BR;
                if (r < I_BR) { transpose_item(a.in[I_WBRB], DM, Wbr_t, 3072, 1024, 0, scr, r, lane); continue; } r -= I_BR;
                if (r < I_BR) { transpose_item(a.in[I_WBRC], DM, Wbr_t, 3072, 2048, 0, scr, r, lane); continue; } r -= I_BR;
                transpose_item(a.in[I_WOUT], DM, Wout_t, DM, 0, 0, scr, r, lane);
            }
        }
    }
    xcd_barrier(xbar);
#pragma unroll 1
    for (int rep2 = 0; rep2 < REP_P2; ++rep2) {
        att::Ptrs P; P.QKV = QKV; P.OB = OB; P.MKp = MKp; P.MVp = MVp; P.KAc = KAc; P.VAc = VAc; P.KBc = KBc; P.VBc = VBc; P.MKc = MKc; P.MVc = MVc;
        P.relb = a.in[I_RELB]; P.subln = a.in[I_SUBLN];
        FRESH_TID();
        { const float s1 = wave_sum(a.in[I_LQ1][lane] * a.in[I_LK1][lane]), s2 = wave_sum(a.in[I_LQ2][lane] * a.in[I_LK2][lane]); P.lam = __expf(s1) - __expf(s2) + 0.2f; }
#pragma unroll 1
        for (int repa = 0; repa < REP_A; ++repa)
        for (int it = vcu2; it < 512; it += G) { const int bh = it >> 2, s = it & 3; att::unit_a<false>(lds, P, bh >> 3, bh & 7, s); att::unit_a<false>(lds, P, bh >> 3, bh & 7, 7 - s); }
        for (int it = vcu2; it < 256; it += G) { const int bh = it >> 1, half = it & 1;
#pragma unroll 1
            for (int i = 0; i < 4; ++i) att::unit_b<false>(lds, P, bh >> 3, bh & 7, 2 * i + half); }
        if (G == 256) {
            const int w = vcu2; int n = 0, u0 = 0, u1 = 0, u2 = 0, u3 = 0;
            if (w >= 64 && w < 160) { n = 2; u0 = 2 * (w - 64); u1 = u0 + 1; }
            else if (w >= 160) { const int j = w - 160; n = j < 32 ? 4 : 3; u0 = 192 + 2 * j; u1 = u0 + 1; u2 = 384 + j; u3 = 480 + j; }
#pragma unroll 1
            for (int i = 0; i < n; ++i) { const int it = i == 0 ? u0 : (i == 1 ? u1 : (i == 2 ? u2 : u3)); att::unit_c<false>(lds, P, it >> 5, (it >> 3) & 3, it & 7); }
        } else
        for (int it = vcu2; it < 512; it += G) att::unit_c<false>(lds, P, it >> 5, (it >> 3) & 3, it & 7);
        for (int it = vcu2; it < 160; it += G) {
            if (it < 64) att::unit_a<true>(lds, P, it >> 3, it & 7, 0);
            else if (it < 128) att::unit_b<true>(lds, P, (it - 64) >> 3, (it - 64) & 7, 0);
            else att::unit_c<true>(lds, P, (it - 128) >> 2, (it - 128) & 3, 0);
        }
    }
    xcd_barrier(xbar);
#pragma unroll 1
    for (int rg = 0; rg < REP_G3; ++rg) {
        pg8::Gemm g{nullptr, nullptr, 0, 0, 3072}; pg8::PhaseSched S; S.so.init(MP, DM, G, vc); S.n0 = 128 * 8; S.n1 = 24; S.G = G; S.c = vc; S.mode = 3; S.nt0 = 48;
        S.A0 = (const char*)OB; S.B0 = (const char*)Wbr_t; S.A1 = (const char*)(OB + (size_t)MP * 3072); S.B1 = S.B0;
        pg8::EpiMerge E{GT, MERGED, PSB};
        pg8::gemm_phase<pg8::EpiMerge, pg8::PhaseSched, true, true>(lds, g, S, E);
        if (G == 256 ? vc >= 24 : true) {
            FRESH_TID(); LAS float* scr = (LAS float*)(lds + wave * 16640);
            constexpr int I_FI = 32 * (2 * DFF / 64), I_FO = (DFF / 64) * 32, NIT = I_FI + I_FO;
            const int nwg = G == 256 ? 232 : G, w0 = G == 256 ? vc - 24 : vc;
            for (int it = w0 * NWAVES + wave; it < NIT; it += nwg * NWAVES) {
                if (it < I_FI) transpose_item(a.in[I_WFFI], 2 * DFF, Wffi_t, DM, 0, 1, scr, it, lane);
                else transpose_item(a.in[I_WFFO], DM, Wffo_t, DFF, 0, 0, scr, it - I_FI, lane);
            }
        }
    }
    xcd_barrier(xbar);
#pragma unroll 1
    for (int rg = 0; rg < REP_G4; ++rg) {
        pg8::Gemm g{nullptr, nullptr, 0, 0, DM}; pg8::PhaseSched S; S.so.init(MP, DM, G, vc); S.n0 = 128 * 8; S.n1 = 96; S.G = G; S.c = vc; S.mode = 4; S.nt0 = 32;
        S.A0 = (const char*)MERGED; S.B0 = (const char*)Wout_t; S.A1 = (const char*)PSB; S.B1 = S.B0;
        pg8::EpiF32 E{T, TS};
        pg8::gemm_phase<pg8::EpiF32, pg8::PhaseSched, true, true>(lds, g, S, E);
    }
    xcd_barrier(xbar);
#pragma unroll 1
    for (int rep5 = 0; rep5 < REP_P5; ++rep5) { FRESH_TID();
        const f32x4* g1 = (const f32x4*)a.in[I_NMIXPOST] + lane; const f32x4* g2 = (const f32x4*)a.in[I_NFFPRE] + lane;
        f32x4 xa[8], xb[8], ta[8], tb[8];
#define P5_LOAD(m_, X, Tv) do { const f32x4* xr_ = (const f32x4*)(a.in[I_XP] + (size_t)(m_) * DM) + lane; const v2u* tb_ = (const v2u*)(T + (size_t)(m_) * DM) + lane; \
        _Pragma("unroll") for (int j = 0; j < 8; ++j) { X[j] = __builtin_nontemporal_load(xr_ + 64 * j); Tv[j] = unpk4(tb_[64 * j]); } } while (0)
#define P5_PROC(m_, X, Tv) do { float s_ = 0.f; _Pragma("unroll") for (int j = 0; j < 8; ++j) s_ += (Tv[j].x * Tv[j].x + Tv[j].y * Tv[j].y) + (Tv[j].z * Tv[j].z + Tv[j].w * Tv[j].w); \
        const float rs_ = rsqrtf(wave_sum(s_) * (1.f / DM) + EPS); float s1_ = 0.f; v2u* x1r_ = (v2u*)(X1 + (size_t)(m_) * DM) + lane; \
        _Pragma("unroll") for (int j = 0; j < 8; ++j) { const f32x4 v_ = X[j] + Tv[j] * rs_ * g1[64 * j]; X[j] = v_; v2u w_; w_.x = pk2(v_.x, v_.y); w_.y = pk2(v_.z, v_.w); x1r_[64 * j] = w_; s1_ += (v_.x * v_.x + v_.y * v_.y) + (v_.z * v_.z + v_.w * v_.w); } \
        const float rs1_ = rsqrtf(wave_sum(s1_) * (1.f / DM) + EPS); v2u* o8_ = (v2u*)(H2 + (size_t)(m_) * DM) + lane; \
        _Pragma("unroll") for (int j = 0; j < 8; ++j) { v2u w_; const f32x4 gq_ = g2[64 * j]; w_.x = pk2(X[j].x * rs1_ * gq_.x, X[j].y * rs1_ * gq_.y); w_.y = pk2(X[j].z * rs1_ * gq_.z, X[j].w * rs1_ * gq_.w); o8_[64 * j] = w_; } } while (0)
        { int m = gw; if (m < MP) P5_LOAD(m, xa, ta);
          while (m < MP) {
            if (m + NGW < MP) P5_LOAD(m + NGW, xb, tb);
            __builtin_amdgcn_sched_barrier(0);
            P5_PROC(m, xa, ta); m += NGW; if (m >= MP) break;
            if (m + NGW < MP) P5_LOAD(m + NGW, xa, ta);
            __builtin_amdgcn_sched_barrier(0);
            P5_PROC(m, xb, tb); m += NGW;
          } }
        for (int m = MP + gw; m < MT; m += NGW) {
            if (m >= MP + MS) { zero_row_bf16(H2 + (size_t)m * DM, lane); continue; }
            const f32x4* tr = (const f32x4*)(TS + (size_t)(m - MP) * DM) + lane; const f32x4* xr_ = (const f32x4*)(a.in[I_XS] + (size_t)(m - MP) * DM) + lane;
#pragma unroll
            for (int j = 0; j < 8; ++j) { xa[j] = xr_[64 * j]; ta[j] = tr[64 * j]; }
#pragma unroll 1
            for (int ks = 1; ks < 12; ++ks) {
#pragma unroll
                for (int j = 0; j < 8; ++j) ta[j] += tr[64 * j + (size_t)ks * 256 * DM / 4]; }
            P5_PROC(m, xa, ta);
        }
#undef P5_LOAD
#undef P5_PROC
    }
    xcd_barrier(xbar);
#pragma unroll 1
    for (int rg = 0; rg < REP_G6; ++rg) {
        pg8::Gemm g{nullptr, nullptr, 0, 0, DM}; pg8::PhaseSched S; S.so.init(MT, 2 * DFF, G, vc); S.n0 = 129 * 44; S.n1 = 0; S.G = G; S.c = vc; S.mode = 0; S.nt0 = 32;
        S.A0 = (const char*)H2; S.B0 = (const char*)Wffi_t; S.A1 = S.A0; S.B1 = S.B0;
        pg8::EpiSwiGLU E{ACT};
        pg8::gemm_phase<pg8::EpiSwiGLU, pg8::PhaseSched, true, true>(lds, g, S, E);
    }
    xcd_barrier(xbar);
#pragma unroll 1
    for (int rg = 0; rg < REP_G7; ++rg) {
        pg8::Gemm g{nullptr, nullptr, 0, 0, DFF}; pg8::PhaseSched S; S.so.init(MP, DM, G, vc); S.n0 = 128 * 8; S.n1 = 88; S.G = G; S.c = vc; S.mode = 7; S.nt0 = 88;
        S.A0 = (const char*)ACT; S.B0 = (const char*)Wffo_t; S.A1 = (const char*)(ACT + (size_t)MP * DFF); S.B1 = S.B0;
        pg8::EpiF32 E{UB, US};
        pg8::gemm_phase<pg8::EpiF32, pg8::PhaseSched, true, true>(lds, g, S, E);
    }
    xcd_barrier(xbar);
#pragma unroll 1
    for (int rep8 = 0; rep8 < REP_P5; ++rep8) { FRESH_TID();
        f32x4 g1[8]; { const f32x4* p1 = (const f32x4*)a.in[I_NFFPOST] + lane;
#pragma unroll
            for (int j = 0; j < 8; ++j) g1[j] = p1[64 * j]; }
        f32x4 ua[8], ub[8]; v2u ca[8], cb[8];
#define P8_LOAD(m_, U, C) do { const v2u* ub_ = (const v2u*)(UB + (size_t)(m_) * DM) + lane; const v2u* x1_ = (const v2u*)(X1 + (size_t)(m_) * DM) + lane; \
        _Pragma("unroll") for (int j = 0; j < 8; ++j) { U[j] = unpk4(ub_[64 * j]); C[j] = x1_[64 * j]; } } while (0)
#define P8_PROC(yrow_, U, C) do { float s_ = 0.f; _Pragma("unroll") for (int j = 0; j < 8; ++j) s_ += (U[j].x * U[j].x + U[j].y * U[j].y) + (U[j].z * U[j].z + U[j].w * U[j].w); \
        const float rs_ = rsqrtf(wave_sum(s_) * (1.f / DM) + EPS); f32x4* yr_ = (f32x4*)(yrow_) + lane; \
        _Pragma("unroll") for (int j = 0; j < 8; ++j) yr_[64 * j] = unpk4(C[j]) + U[j] * rs_ * g1[j]; } while (0)
        { int m = gw; if (m < MP) P8_LOAD(m, ua, ca);
          while (m < MP) {
            if (m + NGW < MP) P8_LOAD(m + NGW, ub, cb);
            __builtin_amdgcn_sched_barrier(0);
            P8_PROC(a.out + OFF_Y + (size_t)m * DM, ua, ca); m += NGW; if (m >= MP) break;
            if (m + NGW < MP) P8_LOAD(m + NGW, ua, ca);
            __builtin_amdgcn_sched_barrier(0);
            P8_PROC(a.out + OFF_Y + (size_t)m * DM, ub, cb); m += NGW;
          } }
        for (int m = MP + gw; m < MP + MS; m += NGW) {
            const f32x4* us = (const f32x4*)(US + (size_t)(m - MP) * DM) + lane; const v2u* x1_ = (const v2u*)(X1 + (size_t)m * DM) + lane;
#pragma unroll
            for (int j = 0; j < 8; ++j) { ca[j] = x1_[64 * j]; ua[j] = us[64 * j]; }
#pragma unroll 1
            for (int ks = 1; ks < 11; ++ks) {
#pragma unroll
                for (int j = 0; j < 8; ++j) ua[j] += us[64 * j + (size_t)ks * 256 * DM / 4]; }
            P8_PROC(a.out + OFF_YS + (size_t)(m - MP) * DM, ua, ca);
        }
#undef P8_LOAD
#undef P8_PROC
    }
}

extern "C" void kernel_launch(void* const* d_in, const int* in_sizes, int n_in, void* d_out, int out_size, void* d_ws, size_t ws_size, hipStream_t stream) {
    static int grid = 0;
    if (grid == 0) {
        if (n_in != 29 || (long)out_size != OUT_TOTAL || ws_size < WS_CTL + 16384) { fprintf(stderr, "kernel_launch: unexpected shapes n_in %d out %d ws %zu\n", n_in, out_size, ws_size); grid = -1; return; }
        int dev = 0, cus = 0, per_cu = 0;
        hipGetDevice(&dev); hipDeviceGetAttribute(&cus, hipDeviceAttributeMultiprocessorCount, dev);
        if (hipFuncSetAttribute((const void*)fwd_megakernel, hipFuncAttributeMaxDynamicSharedMemorySize, LDS_BYTES) != hipSuccess) { fprintf(stderr, "kernel_launch: hipFuncSetAttribute failed\n"); grid = -1; return; }
        hipOccupancyMaxActiveBlocksPerMultiprocessor(&per_cu, (const void*)fwd_megakernel, NWAVES * 64, LDS_BYTES);
        if (per_cu < 1) { fprintf(stderr, "kernel_launch: occupancy query says %d blocks/CU\n", per_cu); per_cu = 1; }
        (void)hipGetLastError();
        grid = cus;
    }
    if (grid < 0) return;
    if (hipMemsetAsync((char*)d_ws + WS_CTL, 0, 16384, stream) != hipSuccess) { fprintf(stderr, "kernel_launch: hipMemsetAsync failed\n"); return; }
    Args a{};
    for (int i = 0; i < 29; ++i) a.in[i] = (const float*)d_in[i];
    a.out = (float*)d_out; a.ws = (unsigned char*)d_ws;
    void* args[] = {&a};
    hipError_t e = hipLaunchCooperativeKernel((const void*)fwd_megakernel, dim3(grid), dim3(NWAVES * 64), args, LDS_BYTES, stream);
    if (e != hipSuccess) fprintf(stderr, "cooperative launch failed: %s (grid %d)\n", hipGetErrorString(e), grid);
}
```
